# Optimizing an MI355X kernel written in HIP

```python
import math
import jax, jax.numpy as jnp
from jax import lax
import numpy as np

D_MODEL = 2048
BATCH = 2
SEQ = 4096
DEPTH = 2
DEC_BATCH = 16
DEC_SEQ = 32
PAST_LEN = 4096

CHUNK = 64
Q_BLOCK = 128
N_ATT_LAYERS = (DEPTH + 1) // 2
N_POOL_LAYERS = DEPTH // 2
H_A = 8
DQK = 64
DV_A = 2 * DQK
W_A = H_A * DV_A
H_B = 8
Q_LORA = 512
KV_LORA = 512
NOPE_DIM = 128
ROPE_DIM = 64
V_DIM = 128
W_B = H_B * V_DIM
ROPE_THETA = 10000.0
W_ATT = W_A + W_B
ATT_SPLITS = [W_A, 2 * W_A, 3 * W_A, 3 * W_A + Q_LORA, 3 * W_A + Q_LORA + KV_LORA,
              3 * W_A + Q_LORA + KV_LORA + ROPE_DIM]
IN_ATT = 3 * W_A + Q_LORA + KV_LORA + ROPE_DIM + W_ATT
POOL_WINDOWS = (2, 4, 8, 16)
N_POOL_GROUPS = 4
W_C = D_MODEL
POOL_GW = W_C // N_POOL_GROUPS
POOL_STATE = max(POOL_WINDOWS) - 1
EPS = 1e-6
SUBLN_EPS = 1e-5
NEG_INF = -1e30
DIFF_SCALE = DQK ** -0.5
MLA_SCALE = (NOPE_DIM + ROPE_DIM) ** -0.5

kernel_name = "chunk_causal_diffattn_mla_pool_stream_step"


def _rmsnorm(x, g, eps=EPS):
    xf = x.astype(jnp.float32)
    y = xf * lax.rsqrt(jnp.mean(xf * xf, axis=-1, keepdims=True) + eps)
    return (y * g.astype(jnp.float32)).astype(x.dtype)


def _rope(x, pos):
    half = ROPE_DIM // 2
    inv = ROPE_THETA ** (-jnp.arange(half, dtype=jnp.float32) / half)
    ang = pos.astype(jnp.float32)[:, None] * inv[None, :]
    cos = jnp.cos(ang)[None, :, None, :]
    sin = jnp.sin(ang)[None, :, None, :]
    x1 = x[..., :half].astype(jnp.float32)
    x2 = x[..., half:].astype(jnp.float32)
    return jnp.concatenate([x1 * cos - x2 * sin, x1 * sin + x2 * cos], axis=-1).astype(x.dtype)


def _lambda_init(layer_idx):
    return 0.8 - 0.6 * math.exp(-0.3 * layer_idx)


def _masked_softmax(logits, q_chunk, k_chunk):
    mask = k_chunk[None, :] <= q_chunk[:, None]
    return jax.nn.softmax(jnp.where(mask, logits, NEG_INF), axis=-1)


def _sweep_query_blocks(fn, q_chunk, qs):
    sq = q_chunk.shape[0]
    if sq <= Q_BLOCK:
        return fn(q_chunk, qs)
    nb = sq // Q_BLOCK
    qc = q_chunk.reshape(nb, Q_BLOCK)
    qb = tuple(jnp.swapaxes(q.reshape(q.shape[0], nb, Q_BLOCK, *q.shape[2:]), 0, 1) for q in qs)
    out = lax.map(lambda a: fn(a[0], a[1]), (qc, qb))
    out = jnp.swapaxes(out, 0, 1)
    return out.reshape(out.shape[0], sq, *out.shape[3:])


def _diff_attention(q, k, v, lam, q_chunk, k_chunk):
    def blk(qc, qs):
        (qb,) = qs
        logits = jnp.einsum('bqhnd,bkhnd->bnhqk', qb, k,
                            preferred_element_type=jnp.float32) * DIFF_SCALE
        p = _masked_softmax(logits, qc, k_chunk)
        w = p[:, 0] - lam * p[:, 1]
        return jnp.einsum('bhqk,bkhe->bqhe', w.astype(v.dtype), v)
    return _sweep_query_blocks(blk, q_chunk, (q,))


def _mla_attention(q_lat, q_pe, c_kv, k_pe, q_chunk, k_chunk):
    def blk(qc, qs):
        ql, qp = qs
        logits = (jnp.einsum('bqhc,bkc->bhqk', ql, c_kv, preferred_element_type=jnp.float32)
                  + jnp.einsum('bqhr,bkr->bhqk', qp, k_pe, preferred_element_type=jnp.float32)) * MLA_SCALE
        p = _masked_softmax(logits, qc, k_chunk)
        return jnp.einsum('bhqk,bkc->bqhc', p.astype(c_kv.dtype), c_kv)
    return _sweep_query_blocks(blk, q_chunk, (q_lat, q_pe))


def _attn_mixer(h, pos, k_pos, lam_init, cache_k, cache_v, cache_ckv, cache_kpe,
                w_in, w_out, lam_q1, lam_k1, lam_q2, lam_k2, g_subln,
                g_qa, w_uq, w_uqr, w_uk, w_uv, g_kva):
    b, s, _ = h.shape
    z = h @ w_in
    qa, ka, va, cq, ckv, kpe, gate = jnp.split(z, ATT_SPLITS, axis=-1)
    qa = qa.reshape(b, s, H_A, 2, DQK)
    ka = ka.reshape(b, s, H_A, DV_A)
    va = va.reshape(b, s, H_A, DV_A)
    cq = _rmsnorm(cq, g_qa)
    q_nope = jnp.einsum('bsc,chd->bshd', cq, w_uq)
    q_pe = _rope(jnp.einsum('bsc,chr->bshr', cq, w_uqr), pos)
    q_lat = jnp.einsum('bshd,chd->bshc', q_nope, w_uk)
    ckv = _rmsnorm(ckv, g_kva)
    kpe = _rope(kpe[:, :, None, :], pos)[:, :, 0, :]
    new_rows = (ka, va, ckv, kpe)
    if cache_k is not None:
        k_all = jnp.concatenate([cache_k.astype(ka.dtype), ka], axis=1)
        v_all = jnp.concatenate([cache_v.astype(va.dtype), va], axis=1)
        ckv_all = jnp.concatenate([cache_ckv.astype(ckv.dtype), ckv], axis=1)
        kpe_all = jnp.concatenate([cache_kpe.astype(kpe.dtype), kpe], axis=1)
    else:
        k_all, v_all, ckv_all, kpe_all = ka, va, ckv, kpe
    sk = k_all.shape[1]
    q_chunk = pos // CHUNK
    k_chunk = k_pos // CHUNK
    lam = (jnp.exp(jnp.sum(lam_q1.astype(jnp.float32) * lam_k1.astype(jnp.float32)))
           - jnp.exp(jnp.sum(lam_q2.astype(jnp.float32) * lam_k2.astype(jnp.float32))) + lam_init)
    o_a = _diff_attention(qa, k_all.reshape(b, sk, H_A, 2, DQK), v_all, lam, q_chunk, k_chunk)
    o_a = _rmsnorm(o_a, g_subln, SUBLN_EPS) * (1.0 - lam_init)
    o_lat = _mla_attention(q_lat, q_pe, ckv_all, kpe_all, q_chunk, k_chunk)
    o_b = jnp.einsum('bshc,chv->bshv', o_lat, w_uv)
    o = jnp.concatenate([o_a.reshape(b, s, W_A), o_b.reshape(b, s, W_B)], axis=-1) * jax.nn.silu(gate)
    return o @ w_out, new_rows


def _pool_mixer(h, pos, prefix, w_in, w_grp, scale, w_out):
    b, s, _ = h.shape
    u, gate = jnp.split(h @ w_in, 2, axis=-1)
    u_ext = jnp.concatenate([prefix.astype(u.dtype), u], axis=1)
    p = POOL_STATE
    cs = jnp.cumsum(u_ext.astype(jnp.float32), axis=1)
    cs = jnp.pad(cs, ((0, 0), (1, 0), (0, 0)))
    end = cs[:, p + 1:p + 1 + s]
    pooled = []
    for g, w in enumerate(POOL_WINDOWS):
        sl = slice(g * POOL_GW, (g + 1) * POOL_GW)
        start = cs[:, p + 1 - w:p + 1 - w + s, sl]
        cnt = jnp.minimum(pos + 1, w).astype(jnp.float32)[None, :, None]
        pooled.append((end[..., sl] - start) / cnt)
    mean = jnp.concatenate(pooled, axis=-1)
    d = (mean - u.astype(jnp.float32)).astype(u.dtype).reshape(b, s, N_POOL_GROUPS, POOL_GW)
    m = jnp.einsum('bsgc,gcd->bsgd', d, w_grp).reshape(b, s, W_C) * scale
    y = (m * jax.nn.silu(gate)) @ w_out
    return y, u_ext[:, -POOL_STATE:]


def _trunk(x, c, pos, k_pos, cache_diff_k, cache_diff_v, cache_mla_ckv, cache_mla_kpe, state_pool,
           g_norm, w_ada, b_ada, w_in_att, w_out_att, lam_q1, lam_k1, lam_q2, lam_k2, g_subln,
           g_qa, w_uq, w_uqr, w_uk, w_uv, g_kva, w_in_pool, w_grp_pool, scale_pool, w_out_pool, g_final):
    b = x.shape[0]
    rows_k, rows_v, rows_ckv, rows_kpe, rows_pool = [], [], [], [], []
    cond = jax.nn.silu(c)
    has_cache = cache_diff_k is not None
    for i in range(DEPTH):
        j = i // 2
        mod = (cond @ w_ada[i] + b_ada[i])[:, None, :]
        shift, scale, gate = jnp.split(mod, 3, axis=-1)
        h = _rmsnorm(x, g_norm[i]) * (1 + scale) + shift
        if i % 2 == 0:
            y, (k_r, v_r, ckv_r, kpe_r) = _attn_mixer(
                h, pos, k_pos, _lambda_init(i),
                cache_diff_k[j] if has_cache else None, cache_diff_v[j] if has_cache else None,
                cache_mla_ckv[j] if has_cache else None, cache_mla_kpe[j] if has_cache else None,
                w_in_att[j], w_out_att[j], lam_q1[j], lam_k1[j], lam_q2[j], lam_k2[j], g_subln[j],
                g_qa[j], w_uq[j], w_uqr[j], w_uk[j], w_uv[j], g_kva[j])
            rows_k.append(k_r)
            rows_v.append(v_r)
            rows_ckv.append(ckv_r)
            rows_kpe.append(kpe_r)
        else:
            prefix = state_pool[j] if has_cache else jnp.zeros((b, POOL_STATE, W_C), x.dtype)
            y, st = _pool_mixer(h, pos, prefix, w_in_pool[j], w_grp_pool[j], scale_pool[j], w_out_pool[j])
            rows_pool.append(st)
        x = x + gate * y
    return (_rmsnorm(x, g_final), jnp.stack(rows_k), jnp.stack(rows_v), jnp.stack(rows_ckv),
            jnp.stack(rows_kpe), jnp.stack(rows_pool))


def setup_inputs(seed: int = 0) -> dict:
    key = jax.random.key(seed)
    ks = jax.random.split(key, 40)

    def nrm(k, shape, s):
        return s * jax.random.normal(k, shape, jnp.float32)

    d = D_MODEL
    return {
        "x_prompt": nrm(ks[0], (BATCH, SEQ, d), 1.0),
        "x_sample": nrm(ks[1], (DEC_BATCH, DEC_SEQ, d), 1.0),
        "c_prompt": nrm(ks[2], (BATCH, d), 1.0),
        "c_sample": nrm(ks[3], (DEC_BATCH, d), 1.0),
        "cache_diff_k": nrm(ks[4], (N_ATT_LAYERS, DEC_BATCH, PAST_LEN, H_A, DV_A), 1.0),
        "cache_diff_v": nrm(ks[5], (N_ATT_LAYERS, DEC_BATCH, PAST_LEN, H_A, DV_A), 1.0),
        "cache_mla_ckv": nrm(ks[6], (N_ATT_LAYERS, DEC_BATCH, PAST_LEN, KV_LORA), 1.0),
        "cache_mla_kpe": nrm(ks[7], (N_ATT_LAYERS, DEC_BATCH, PAST_LEN, ROPE_DIM), 1.0),
        "state_pool": nrm(ks[8], (N_POOL_LAYERS, DEC_BATCH, POOL_STATE, W_C), 1.0),
        "g_norm": 1.0 + nrm(ks[9], (DEPTH, d), 0.05),
        "w_ada": nrm(ks[10], (DEPTH, d, 3 * d), 0.2 * d ** -0.5),
        "b_ada": nrm(ks[11], (DEPTH, 3 * d), 0.02),
        "w_in_att": nrm(ks[12], (N_ATT_LAYERS, d, IN_ATT), d ** -0.5),
        "w_out_att": nrm(ks[13], (N_ATT_LAYERS, W_ATT, d), W_ATT ** -0.5),
        "lam_q1": nrm(ks[14], (N_ATT_LAYERS, DQK), 0.1),
        "lam_k1": nrm(ks[15], (N_ATT_LAYERS, DQK), 0.1),
        "lam_q2": nrm(ks[16], (N_ATT_LAYERS, DQK), 0.1),
        "lam_k2": nrm(ks[17], (N_ATT_LAYERS, DQK), 0.1),
        "g_subln": 1.0 + nrm(ks[18], (N_ATT_LAYERS, DV_A), 0.05),
        "g_qa": 1.0 + nrm(ks[19], (N_ATT_LAYERS, Q_LORA), 0.05),
        "w_uq": nrm(ks[20], (N_ATT_LAYERS, Q_LORA, H_B, NOPE_DIM), Q_LORA ** -0.5),
        "w_uqr": nrm(ks[21], (N_ATT_LAYERS, Q_LORA, H_B, ROPE_DIM), Q_LORA ** -0.5),
        "w_uk": nrm(ks[22], (N_ATT_LAYERS, KV_LORA, H_B, NOPE_DIM), KV_LORA ** -0.5),
        "w_uv": nrm(ks[23], (N_ATT_LAYERS, KV_LORA, H_B, V_DIM), KV_LORA ** -0.5),
        "g_kva": 1.0 + nrm(ks[24], (N_ATT_LAYERS, KV_LORA), 0.05),
        "w_in_pool": nrm(ks[25], (N_POOL_LAYERS, d, 2 * W_C), d ** -0.5),
        "w_grp_pool": nrm(ks[26], (N_POOL_LAYERS, N_POOL_GROUPS, POOL_GW, POOL_GW), POOL_GW ** -0.5),
        "scale_pool": 1.0 + nrm(ks[27], (N_POOL_LAYERS, W_C), 0.1),
        "w_out_pool": nrm(ks[28], (N_POOL_LAYERS, W_C, d), W_C ** -0.5),
        "g_final": 1.0 + nrm(ks[29], (d,), 0.05),
    }


def reference(x_prompt, x_sample, c_prompt, c_sample, cache_diff_k, cache_diff_v, cache_mla_ckv,
              cache_mla_kpe, state_pool, g_norm, w_ada, b_ada, w_in_att, w_out_att, lam_q1, lam_k1,
              lam_q2, lam_k2, g_subln, g_qa, w_uq, w_uqr, w_uk, w_uv, g_kva, w_in_pool, w_grp_pool,
              scale_pool, w_out_pool, g_final):
    weights = (g_norm, w_ada, b_ada, w_in_att, w_out_att, lam_q1, lam_k1, lam_q2, lam_k2, g_subln,
               g_qa, w_uq, w_uqr, w_uk, w_uv, g_kva, w_in_pool, w_grp_pool, scale_pool, w_out_pool, g_final)
    s_p = x_prompt.shape[1]
    pos_p = jnp.arange(s_p, dtype=jnp.int32)
    y_prompt, pk, pv, pckv, pkpe, ppool = _trunk(
        x_prompt, c_prompt, pos_p, pos_p, None, None, None, None, None, *weights)
    past = cache_diff_k.shape[2]
    n = x_sample.shape[1]
    pos_s = past + jnp.arange(n, dtype=jnp.int32)
    k_pos_s = jnp.arange(past + n, dtype=jnp.int32)
    y_sample, sk, sv, sckv, skpe, spool = _trunk(
        x_sample, c_sample, pos_s, k_pos_s, cache_diff_k, cache_diff_v, cache_mla_ckv, cache_mla_kpe,
        state_pool, *weights)
    return (y_prompt, y_sample, pk, pv, pckv, pkpe, ppool, sk, sv, sckv, skpe, spool)
```

```cpp
#include <hip/hip_runtime.h>
#include <hip/hip_cooperative_groups.h>
#include <cstdio>
#include <type_traits>
namespace cg = cooperative_groups;

typedef unsigned short bf16_t;
typedef short bf16x8 __attribute__((ext_vector_type(8)));
typedef short s16x4 __attribute__((ext_vector_type(4)));
typedef float f32x4 __attribute__((ext_vector_type(4)));
typedef float f32x2 __attribute__((ext_vector_type(2)));
typedef unsigned u32x4 __attribute__((ext_vector_type(4)));
typedef unsigned u32x2 __attribute__((ext_vector_type(2)));
#define LAS __attribute__((address_space(3)))
#define DI __device__ __forceinline__

constexpr int XCD_BAR_WORDS_C = 3456;
constexpr int DM = 2048, TP = 8192, TS = 512, TT = 8704, SEQ = 4096, PAST = 4096, NSB = 16, NB = 18;
constexpr int IN_ATT = 6208, IN_ATT_PAD = 6400;
constexpr float LOG2E = 1.4426950408889634f;
constexpr float C_DIFF = 0.125f * LOG2E;
constexpr float C_MLA = 0.07216878364870323f * LOG2E;
constexpr size_t O_Y = 0, O_KP = 17825792, O_VP = 26214400, O_CKVP = 34603008, O_KPEP = 38797312, O_POOLP = 39321600,
                 O_KS = 39383040, O_VS = 39907328, O_CKVS = 40431616, O_KPES = 40693760, O_POOLS = 40726528;
constexpr size_t al256(size_t x) { return (x + 255) / 256 * 256; }
constexpr size_t W_WINT = 0;
constexpr size_t W_WOUTT = W_WINT + al256((size_t)IN_ATT_PAD * 2048 * 2);
constexpr size_t W_WQT = W_WOUTT + al256((size_t)2048 * 2048 * 2);
constexpr size_t W_WKVT = W_WQT + al256((size_t)1536 * 512 * 2);
constexpr size_t W_WUKP = W_WKVT + al256((size_t)2304 * 512 * 2);
constexpr size_t W_WINPT = W_WUKP + al256((size_t)8 * 512 * 256 * 2);
constexpr size_t W_WGRPT = W_WINPT + al256((size_t)4096 * 2048 * 2);
constexpr size_t W_WOUTPT = W_WGRPT + al256((size_t)4 * 512 * 512 * 2);
constexpr size_t W_MODP = W_WOUTPT + al256((size_t)2048 * 2048 * 2);
constexpr size_t W_MOD = W_MODP + al256((size_t)8 * 2 * NB * 6144 * 4);
constexpr size_t W_ROPE = W_MOD + al256((size_t)2 * NB * 6144 * 4);
constexpr size_t W_CNT = W_ROPE + al256((size_t)4128 * 32 * 8);
constexpr size_t W_BAR = W_CNT + 256;
constexpr size_t W_H = W_BAR + al256((size_t)XCD_BAR_WORDS_C * 4);
constexpr size_t W_QA = W_H + al256((size_t)TT * 2048 * 2);
constexpr size_t W_KA = W_QA + al256((size_t)TT * 1024 * 2);
constexpr size_t W_VA = W_KA + al256((size_t)TT * 1024 * 2);
constexpr size_t W_CQ = W_VA + al256((size_t)TT * 1024 * 2);
constexpr size_t W_CKVR = W_CQ + al256((size_t)TT * 512 * 4);
constexpr size_t W_SG = W_CKVR + al256((size_t)TT * 512 * 4);
constexpr size_t W_CQN = W_SG + al256((size_t)TT * 2048 * 2);
constexpr size_t W_CKVN = W_CQN + al256((size_t)TT * 512 * 2);
constexpr size_t W_KPE = W_CKVN + al256((size_t)TT * 512 * 2);
constexpr size_t W_QM = W_KPE + al256((size_t)TT * 64 * 2);
constexpr size_t W_KM = W_QM + al256((size_t)TP * 1536 * 2);
constexpr size_t W_VM = W_KM + al256((size_t)TP * 1024 * 2);
constexpr size_t W_QNS = W_VM + al256((size_t)TP * 1024 * 2);
constexpr size_t W_QS = W_QNS + al256((size_t)TS * 1024 * 2);
constexpr size_t W_CC = W_QS + al256((size_t)NSB * 256 * 576 * 2);
constexpr size_t W_OA = W_CC + al256((size_t)NSB * 4160 * 576 * 2);
constexpr size_t W_OPD = W_OA + al256((size_t)TP * 8 * 2 * 128 * 4);
constexpr size_t W_MLD = W_OPD + al256((size_t)NSB * 8 * 2 * 2 * 32 * 128 * 4);
constexpr size_t W_OPM = W_MLD + al256((size_t)NSB * 8 * 2 * 2 * 32 * 2 * 4);
constexpr size_t W_MLM = W_OPM + al256((size_t)NSB * 256 * 4 * 512 * 4);
constexpr size_t W_OLAT = W_MLM + al256((size_t)NSB * 256 * 4 * 2 * 4);
constexpr size_t W_O = W_OLAT + al256((size_t)TS * 8 * 512 * 2);
constexpr size_t W_X1 = W_O + al256((size_t)TT * 2048 * 2);
constexpr size_t W_U = W_X1 + al256((size_t)TT * 2048 * 4);
constexpr size_t W_D = W_U + al256((size_t)TT * 2048 * 4);
constexpr size_t W_MX = W_D + al256((size_t)TT * 2048 * 2);
constexpr size_t W_END = W_MX + al256((size_t)TT * 2048 * 2);

constexpr int DYN_LDS = 149504;
#ifndef REP_P0
#define REP_P0 1
#endif
#ifndef REP_P4
#define REP_P4 1
#endif
#ifndef REP_G
#define REP_G 1
#endif
#ifndef REP_E
#define REP_E 1
#endif
#define REP_P1 1
#define REP_P2B 1
#define REP_P4B 1
#define REP_P6 1
#define REP_P8A 1
#define REP_PM 1
#define REP_SM 1
#define REP_PD 1
#define REP_SD 1

struct Params { const float* in[30]; float* out; char* ws; };

typedef __bf16 bf16x2_t __attribute__((ext_vector_type(2)));
DI unsigned cvtpk(float lo, float hi) { const f32x2 v = {lo, hi}; return __builtin_bit_cast(unsigned, __builtin_convertvector(v, bf16x2_t)); }
DI int my_tid() { int t = threadIdx.x; asm volatile("" : "+v"(t)); return t; }
DI float bf2f(unsigned short b) { return __uint_as_float(((unsigned)b) << 16); }
DI float bflo(unsigned w) { return __uint_as_float(w << 16); }
DI float bfhi(unsigned w) { return __uint_as_float(w & 0xffff0000u); }
DI float silu(float x) { return x * __builtin_amdgcn_rcpf(1.f + __expf(-x)); }
DI u32x2 pack4(f32x4 v) { u32x2 w; w.x = cvtpk(v[0], v[1]); w.y = cvtpk(v[2], v[3]); return w; }
DI f32x4 unpack4(u32x2 w) { return (f32x4){bflo(w.x), bfhi(w.x), bflo(w.y), bfhi(w.y)}; }
DI float quad_max(float v) { auto a = __builtin_amdgcn_permlane16_swap(__float_as_uint(v), __float_as_uint(v), false, false); v = fmaxf(__uint_as_float(a[0]), __uint_as_float(a[1]));
  auto b = __builtin_amdgcn_permlane32_swap(__float_as_uint(v), __float_as_uint(v), false, false); return fmaxf(__uint_as_float(b[0]), __uint_as_float(b[1])); }
DI float quad_sum(float v) { auto a = __builtin_amdgcn_permlane16_swap(__float_as_uint(v), __float_as_uint(v), false, false); v = __uint_as_float(a[0]) + __uint_as_float(a[1]);
  auto b = __builtin_amdgcn_permlane32_swap(__float_as_uint(v), __float_as_uint(v), false, false); return __uint_as_float(b[0]) + __uint_as_float(b[1]); }
DI float wave_sum(float v) { for (int o = 32; o >= 1; o >>= 1) v += __shfl_xor(v, o); return v; }
DI int tok_batch(int tok) { return tok < TP ? (tok >> 12) : 2 + ((tok - TP) >> 5); }
DI int tok_pos(int tok) { return tok < TP ? (tok & 4095) : PAST + ((tok - TP) & 31); }
DI const float* x_row(const Params& p, int tok) { return tok < TP ? p.in[0] + (size_t)tok * DM : p.in[1] + (size_t)(tok - TP) * DM; }


#define XB_TMO      128
#define XB_XCNT(j)  (256  + 64 * (j))
#define XB_XSUB(j)  (1280 + 64 * (j))
#define XB_XGEN(j)  (2304 + 64 * (j))
#define XB_TOP      3328
#define XB_TOPGEN   3392
#define XCD_BAR_WORDS 3456
#define XB_SPIN_CAP (1u << 22)
DI unsigned xb_ld(unsigned* p)              { return __hip_atomic_load(p, __ATOMIC_RELAXED, __HIP_MEMORY_SCOPE_AGENT); }
DI unsigned xb_add(unsigned* p, unsigned v) { return __hip_atomic_fetch_add(p, v, __ATOMIC_RELAXED, __HIP_MEMORY_SCOPE_AGENT); }
DI unsigned xb_xcc_id() { return (unsigned)__builtin_amdgcn_s_getreg((3 << 11) | 20) & 0xFu; }
#define XB_SPIN(cond, bar) do { unsigned _sp = 0; while (cond) { __builtin_amdgcn_s_sleep(1); \
    if ((++_sp & 255u) == 0u) { if (xb_ld(&(bar)[XB_TMO])) break; if (_sp > XB_SPIN_CAP) { atomicAdd(&(bar)[XB_TMO], 1u); break; } } } } while (0)
DI void xcd_barrier_post(unsigned* bar) { if (threadIdx.x == 0) (void)xb_add(&bar[XB_XCNT(xb_xcc_id())], 1u); }
DI void xcd_barrier_complete(unsigned* bar, unsigned x, unsigned& nloc, unsigned& nx) {
  const unsigned G = gridDim.x; unsigned sum, cnt, mine, sp = 0u;
  for (;;) { sum = 0u; cnt = 0u; mine = 0u;
#pragma unroll
    for (unsigned j = 0; j < 16; ++j) { const unsigned c = xb_ld(&bar[XB_XCNT(j)]); sum += c; cnt += (c > 0u) ? 1u : 0u; mine = (j == x) ? c : mine; }
    if (sum == G) break;
    __builtin_amdgcn_s_sleep(1);
    if ((++sp & 255u) == 0u) { if (xb_ld(&bar[XB_TMO])) break; if (sp > XB_SPIN_CAP) { atomicAdd(&bar[XB_TMO], 1u); break; } } }
  nloc = mine > 0u ? mine : 1u; nx = cnt > 0u ? cnt : 1u;
}
DI void xcd_barrier(unsigned* bar, volatile LAS unsigned* st) {
  asm volatile("s_waitcnt vmcnt(0)" ::: "memory");
  __syncthreads();
  if (threadIdx.x == 0) {
    const unsigned x = xb_xcc_id();
    __builtin_amdgcn_s_waitcnt(0);
    unsigned nloc = st[0], nx = st[1];
    if (nloc == 0u) { xcd_barrier_complete(bar, x, nloc, nx); st[0] = nloc; st[1] = nx; }
    const unsigned old = xb_add(&bar[XB_XSUB(x)], 1u);
    const unsigned gen = old / nloc;
    if (old + 1u == (gen + 1u) * nloc) {
      __builtin_amdgcn_fence(__ATOMIC_RELEASE, "agent");
      asm volatile("s_waitcnt vmcnt(0)" ::: "memory");
      const unsigned og = xb_add(&bar[XB_TOP], 1u);
      const unsigned tg = og / nx;
      if (og + 1u == (tg + 1u) * nx) xb_add(&bar[XB_TOPGEN], 1u);
      else XB_SPIN(xb_ld(&bar[XB_TOPGEN]) == tg, bar);
      __builtin_amdgcn_fence(__ATOMIC_ACQUIRE, "agent");
      xb_add(&bar[XB_XGEN(x)], 1u);
      asm volatile("s_waitcnt vmcnt(0)" ::: "memory");
    } else {
      XB_SPIN(xb_ld(&bar[XB_XGEN(x)]) == gen, bar);
      __builtin_amdgcn_fence(__ATOMIC_ACQUIRE, "agent");
      asm volatile("s_waitcnt vmcnt(0)" ::: "memory");
    }
  }
  __syncthreads();
}

DI void flag_publish(unsigned* flag) { __threadfence(); __syncthreads(); if (threadIdx.x == 0) (void)xb_add(flag, 1u); }
DI void flag_wait(unsigned* flag, unsigned need) {
  if (threadIdx.x == 0) { unsigned sp = 0; while (xb_ld(flag) < need) { __builtin_amdgcn_s_sleep(4); if (++sp > (1u << 24)) break; } }
  __syncthreads();
  __builtin_amdgcn_fence(__ATOMIC_ACQUIRE, "agent");
  asm volatile("s_waitcnt vmcnt(0)" ::: "memory");
}
constexpr int BK = 64, HALF = 128, HTB = HALF * BK * 2;
DI int lds_byte(int r, int c) { const int st = (r >> 4) * 2 + (c >> 5), rr = r & 15, cc = c & 31, ob = rr * 64 + cc * 2; return st * 1024 + (ob ^ (((ob >> 9) & 1) << 5)); }
DI void stage_rc(int b, int& R, int& C) { const int st = b / 1024, sb = b % 1024, swz = sb ^ (((sb >> 9) & 1) << 5); R = (st >> 1) * 16 + swz / 64; C = (st & 1) * 32 + (swz % 64) / 2; }

template <class Epi>
DI void gemm_tile(LAS char* lds, const bf16_t* __restrict__ A, int lda, const bf16_t* __restrict__ Bt, int ldb, int K, const Epi& epi,
                  bool pre = false, const bf16_t* nA = nullptr, const bf16_t* nB = nullptr) {
  const int tid = my_tid(), wid = __builtin_amdgcn_readfirstlane(tid >> 6), lane = tid & 63, wr = wid >> 2, wc = wid & 3, fr = lane & 15, fq = lane >> 4;
  int offA[2], offB[2];
#pragma unroll
  for (int i = 0; i < 2; ++i) { int R, C; stage_rc(tid * 16 + i * 8192, R, C); offA[i] = R * lda + C; offB[i] = R * ldb + C; }
  const unsigned ldsw = (unsigned)wid * 1024u;
  const int aoff = lds_byte(wr * 64 + fr, fq * 8), boff = lds_byte(wc * 32 + fr, fq * 8);
  const size_t hA = (size_t)HALF * lda, hB = (size_t)HALF * ldb;
#define G_SA(b, h) (((b) * 2 + (h)) * HTB)
#define G_SB(b, h) ((4 + (b) * 2 + (h)) * HTB)
#define G_STAGE(bufoff, gptr, off) do { _Pragma("unroll") for (int _i = 0; _i < 2; ++_i) \
    __builtin_amdgcn_global_load_lds((const unsigned*)((gptr) + (off)[_i]), (LAS unsigned*)(lds + (bufoff) + ldsw + _i * 8192), 16, 0, 0); } while (0)
#define G_LDA(dst, b, h) do { _Pragma("unroll") for (int m = 0; m < 4; ++m) _Pragma("unroll") for (int k = 0; k < 2; ++k) dst[m][k] = *(const LAS bf16x8*)(lds + G_SA(b, h) + aoff + m * 2048 + k * 1024); } while (0)
#define G_LDB(dst, b, h) do { _Pragma("unroll") for (int n = 0; n < 2; ++n) _Pragma("unroll") for (int k = 0; k < 2; ++k) dst[n][k] = *(const LAS bf16x8*)(lds + G_SB(b, h) + boff + n * 2048 + k * 1024); } while (0)
#define G_MMA(ai, bj, At, Bq) do { __builtin_amdgcn_s_setprio(1); _Pragma("unroll") for (int m = 0; m < 4; ++m) _Pragma("unroll") for (int n = 0; n < 2; ++n) _Pragma("unroll") for (int k = 0; k < 2; ++k) \
    acc[ai][bj][m][n] = __builtin_amdgcn_mfma_f32_16x16x32_bf16(Bq[n][k], At[m][k], acc[ai][bj][m][n], 0, 0, 0); __builtin_amdgcn_s_setprio(0); } while (0)
#define G_WV(n) asm volatile("s_waitcnt vmcnt(" #n ")" ::: "memory")
#define G_WL(n) asm volatile("s_waitcnt lgkmcnt(" #n ")" ::: "memory")
#define G_BAR __builtin_amdgcn_s_barrier()
#define G_SCHED __builtin_amdgcn_sched_barrier(0)
  f32x4 acc[2][2][4][2];
#pragma unroll
  for (int a = 0; a < 2; ++a)
#pragma unroll
    for (int b = 0; b < 2; ++b)
#pragma unroll
      for (int m = 0; m < 4; ++m)
#pragma unroll
        for (int n = 0; n < 2; ++n) acc[a][b][m][n] = (f32x4){0.f, 0.f, 0.f, 0.f};
  bf16x8 At[4][2], B0[2][2], B1[2][2];
  const int nt = K / BK;
  const bf16_t* pA = A; const bf16_t* pB = Bt;
  if (!pre) { G_STAGE(G_SB(0, 0), pB, offB); G_STAGE(G_SA(0, 0), pA, offA); G_STAGE(G_SB(0, 1), pB + hB, offB); G_STAGE(G_SA(0, 1), pA + hA, offA); }
  if (wr == 1) G_BAR;
  G_WV(4); G_BAR;
  G_STAGE(G_SB(1, 0), pB + BK, offB); G_STAGE(G_SA(1, 0), pA + BK, offA); G_STAGE(G_SB(1, 1), pB + hB + BK, offB);
  G_WV(6); G_BAR;
  for (int t = 0; t < nt - 2; t += 2) {
    const bf16_t* a1 = pA + (t + 1) * BK; const bf16_t* a2 = pA + (t + 2) * BK; const bf16_t* a3 = pA + (t + 3) * BK;
    const bf16_t* b2 = pB + (t + 2) * BK; const bf16_t* b3 = pB + (t + 3) * BK;
    G_LDB(B0, 0, 0); G_SCHED; G_LDA(At, 0, 0); G_STAGE(G_SA(1, 1), a1 + hA, offA);
    G_WL(8); G_BAR; G_WL(0); G_MMA(0, 0, At, B0); G_BAR; G_SCHED;
    G_LDB(B1, 0, 1); G_STAGE(G_SB(0, 0), b2, offB);
    G_BAR; G_WL(0); G_MMA(0, 1, At, B1); G_BAR;
    G_LDA(At, 0, 1); G_STAGE(G_SA(0, 0), a2, offA);
    G_BAR; G_WL(0); G_MMA(1, 0, At, B0); G_BAR; G_SCHED;
    G_STAGE(G_SB(0, 1), b2 + hB, offB);
    G_WV(6); G_BAR; G_MMA(1, 1, At, B1); G_BAR;
    G_LDB(B0, 1, 0); G_SCHED; G_LDA(At, 1, 0); G_STAGE(G_SA(0, 1), a2 + hA, offA);
    G_WL(8); G_BAR; G_WL(0); G_MMA(0, 0, At, B0); G_BAR; G_SCHED;
    G_LDB(B1, 1, 1); G_STAGE(G_SB(1, 0), b3, offB);
    G_BAR; G_WL(0); G_MMA(0, 1, At, B1); G_BAR;
    G_LDA(At, 1, 1); G_STAGE(G_SA(1, 0), a3, offA);
    G_BAR; G_WL(0); G_MMA(1, 0, At, B0); G_BAR; G_SCHED;
    G_STAGE(G_SB(1, 1), b3 + hB, offB);
    G_WV(6); G_BAR; G_MMA(1, 1, At, B1); G_BAR;
  }
  { G_LDB(B0, 0, 0); G_LDA(At, 0, 0); G_STAGE(G_SA(1, 1), pA + (nt - 1) * BK + hA, offA);
    G_BAR; G_WL(0); G_MMA(0, 0, At, B0); G_BAR;
    G_LDB(B1, 0, 1); G_BAR; G_WL(0); G_MMA(0, 1, At, B1); G_BAR;
    G_LDA(At, 0, 1); G_WV(4); G_BAR; G_WL(0); G_MMA(1, 0, At, B0); G_MMA(1, 1, At, B1); G_BAR; }
  { G_LDB(B0, 1, 0); G_LDA(At, 1, 0); G_WV(2); G_BAR; G_WL(0); G_MMA(0, 0, At, B0); G_BAR;
    G_LDB(B1, 1, 1); G_WV(0); G_BAR; G_WL(0); G_MMA(0, 1, At, B1); G_BAR;
    G_LDA(At, 1, 1); G_BAR; G_WL(0); G_MMA(1, 0, At, B0); G_MMA(1, 1, At, B1); G_BAR; }
  if (wr == 0) G_BAR;
  if (nA) { G_STAGE(G_SB(0, 0), nB, offB); G_STAGE(G_SA(0, 0), nA, offA); G_STAGE(G_SB(0, 1), nB + hB, offB); G_STAGE(G_SA(0, 1), nA + hA, offA); }
  epi(acc, wr, wc, fr, fq);
#undef G_SA
#undef G_SB
#undef G_STAGE
#undef G_LDA
#undef G_LDB
#undef G_MMA
}

DI void tile_map(int L, int nM, int nN, int& pm, int& pn) {
  const int nwg = nM * nN, q = nwg / 8, r = nwg % 8, xcd = L % 8, off = L / 8;
  const int w = (xcd < r ? xcd * (q + 1) : r * (q + 1) + (xcd - r) * q) + off;
  const int nig = 8 * nN, gid = w / nig, fm = gid * 8, gsz = (nM - fm) < 8 ? (nM - fm) : 8;
  pm = fm + ((w % nig) % gsz); pn = (w % nig) / gsz;
}
#define EPI_LOOP(...) \
  _Pragma("unroll") for (int ai = 0; ai < 2; ++ai) _Pragma("unroll") for (int m = 0; m < 4; ++m) { const int rl = ai * 128 + wr * 64 + m * 16 + fr; \
    _Pragma("unroll") for (int bj = 0; bj < 2; ++bj) _Pragma("unroll") for (int n = 0; n < 2; ++n) { const int cl = bj * 128 + wc * 32 + n * 16 + fq * 4; const f32x4 v = acc[ai][bj][m][n]; __VA_ARGS__ } }

typedef f32x4 AccT[2][2][4][2];

struct EpiInAtt {
  const Params* p; int pm, pn;
  DI void operator()(const AccT& acc, int wr, int wc, int fr, int fq) const {
    char* ws = p->ws; float* out = p->out;
    const int r0 = pm * 256, c0 = pn * 256;
    if (pn < 4) { bf16_t* QA = (bf16_t*)(ws + W_QA);
      EPI_LOOP({ *(u32x2*)(QA + (size_t)(r0 + rl) * 1024 + c0 + cl) = pack4(v * C_DIFF); })
    } else if (pn < 12) {
      const bool isk = pn < 8; bf16_t* KB = (bf16_t*)(ws + (isk ? W_KA : W_VA)); const int cb = c0 - (isk ? 1024 : 2048);
      EPI_LOOP({ const int tok = r0 + rl; float* o = tok < TP ? out + (isk ? O_KP : O_VP) + (size_t)tok * 1024 : out + (isk ? O_KS : O_VS) + (size_t)(tok - TP) * 1024;
                 *(f32x4*)(o + cb + cl) = v; *(u32x2*)(KB + (size_t)tok * 1024 + cb + cl) = pack4(v); })
    } else if (pn < 16) {
      float* F = (float*)(ws + (pn < 14 ? W_CQ : W_CKVR)); const int cb = c0 - (pn < 14 ? 3072 : 3584);
      EPI_LOOP({ *(f32x4*)(F + (size_t)(r0 + rl) * 512 + cb + cl) = v; })
    } else {
      bf16_t* SG = (bf16_t*)(ws + W_SG); bf16_t* KPE = (bf16_t*)(ws + W_KPE); bf16_t* CC = (bf16_t*)(ws + W_CC); const float* ROPE = (const float*)(ws + W_ROPE);
      EPI_LOOP({ const int tok = r0 + rl; const int col = c0 + cl;
        if (col >= 4160) { if (col < IN_ATT) { f32x4 s; s[0] = silu(v[0]); s[1] = silu(v[1]); s[2] = silu(v[2]); s[3] = silu(v[3]); *(u32x2*)(SG + (size_t)tok * 2048 + (col - 4160)) = pack4(s); } }
        else { const int r = (col - 4096) >> 1; const int pos = tok_pos(tok); const f32x4 cs = *(const f32x4*)(ROPE + ((size_t)pos * 32 + r) * 2);
          const float a0 = v[0] * cs[0] - v[1] * cs[1], b0 = v[0] * cs[1] + v[1] * cs[0], a1 = v[2] * cs[2] - v[3] * cs[3], b1 = v[2] * cs[3] + v[3] * cs[2];
          float* o = tok < TP ? out + O_KPEP + (size_t)tok * 64 : out + O_KPES + (size_t)(tok - TP) * 64;
          *(f32x2*)(o + r) = (f32x2){a0, a1}; *(f32x2*)(o + 32 + r) = (f32x2){b0, b1};
          const unsigned wa = cvtpk(a0, a1), wb = cvtpk(b0, b1);
          *(unsigned*)(KPE + (size_t)tok * 64 + r) = wa; *(unsigned*)(KPE + (size_t)tok * 64 + 32 + r) = wb;
          if (tok >= TP) { const int bs = (tok - TP) >> 5, s = (tok - TP) & 31; bf16_t* cc = CC + ((size_t)bs * 4160 + 4096 + s) * 576 + 512; *(unsigned*)(cc + r) = wa; *(unsigned*)(cc + 32 + r) = wb; } } })
    }
  }
};
struct EpiQ {
  const Params* p; int pm, pn;
  DI void operator()(const AccT& acc, int wr, int wc, int fr, int fq) const {
    char* ws = p->ws; const int r0 = pm * 256, c0 = pn * 256;
    bf16_t* QM = (bf16_t*)(ws + W_QM); bf16_t* QNS = (bf16_t*)(ws + W_QNS); bf16_t* QS = (bf16_t*)(ws + W_QS); const float* ROPE = (const float*)(ws + W_ROPE);
    if (pn < 4) {
      EPI_LOOP({ const int tok = r0 + rl; const int col = c0 + cl; const int h = col >> 7, d = col & 127;
        const f32x4 vs = v * C_MLA;
        if (tok < TP) *(u32x2*)(QM + (size_t)tok * 1536 + h * 192 + d) = pack4(vs); else *(u32x2*)(QNS + (size_t)(tok - TP) * 1024 + col) = pack4(vs); })
    } else {
      EPI_LOOP({ const int tok = r0 + rl; const int col = c0 + cl - 1024; const int h = col >> 6, r = (col & 63) >> 1; const int pos = tok_pos(tok);
        const f32x4 cs = *(const f32x4*)(ROPE + ((size_t)pos * 32 + r) * 2);
        const float a0 = (v[0] * cs[0] - v[1] * cs[1]) * C_MLA, b0 = (v[0] * cs[1] + v[1] * cs[0]) * C_MLA, a1 = (v[2] * cs[2] - v[3] * cs[3]) * C_MLA, b1 = (v[2] * cs[3] + v[3] * cs[2]) * C_MLA;
        bf16_t* q = tok < TP ? QM + (size_t)tok * 1536 + h * 192 + 128 : QS + ((size_t)((tok - TP) >> 5) * 256 + h * 32 + ((tok - TP) & 31)) * 576 + 512;
        *(unsigned*)(q + r) = cvtpk(a0, a1); *(unsigned*)(q + 32 + r) = cvtpk(b0, b1); })
    }
  }
};
struct EpiBf16 {
  bf16_t* dst; int ld; int r0; int cbase;
  DI void operator()(const AccT& acc, int wr, int wc, int fr, int fq) const {
    EPI_LOOP({ *(u32x2*)(dst + (size_t)(r0 + rl) * ld + cbase + cl) = pack4(v); })
  }
};
struct EpiQlat {
  bf16_t* QS; int h; int r0; int c0;
  DI void operator()(const AccT& acc, int wr, int wc, int fr, int fq) const {
    EPI_LOOP({ const int t = r0 + rl; *(u32x2*)(QS + ((size_t)(t >> 5) * 256 + h * 32 + (t & 31)) * 576 + c0 + cl) = pack4(v); })
  }
};
struct EpiOb {
  bf16_t* O; const bf16_t* SG; int h; int r0;
  DI void operator()(const AccT& acc, int wr, int wc, int fr, int fq) const {
    EPI_LOOP({ if (cl < 128) { const size_t idx = (size_t)(TP + r0 + rl) * 2048 + 1024 + h * 128 + cl; const f32x4 g = unpack4(*(const u32x2*)(SG + idx)); *(u32x2*)(O + idx) = pack4(v * g); } })
  }
};
struct EpiRes {
  const Params* p; const float* base;   float* dst; const float* gate;   int pm, pn;
  DI void operator()(const AccT& acc, int wr, int wc, int fr, int fq) const {
    const int r0 = pm * 256, c0 = pn * 256;
    EPI_LOOP({ const int tok = r0 + rl; const int col = c0 + cl; const float* br = base ? base + (size_t)tok * DM : x_row(*p, tok);
      const f32x4 b = *(const f32x4*)(br + col); const f32x4 g = *(const f32x4*)(gate + (size_t)tok_batch(tok) * 6144 + col);
      *(f32x4*)(dst + (size_t)tok * DM + col) = b + g * v; })
  }
};
struct EpiPart {
  float* dst;
  DI void operator()(const AccT& acc, int wr, int wc, int fr, int fq) const {
    EPI_LOOP({ *(f32x4*)(dst + (size_t)rl * 4096 + cl) = v; })
  }
};
template <int NCH> DI f32x4 part_sum(const float* PART, int row, int col) { f32x4 a = *(const f32x4*)(PART + (size_t)row * 4096 + col);
#pragma unroll
  for (int c = 1; c < NCH; ++c) a += *(const f32x4*)(PART + ((size_t)c * 512 + row) * 4096 + col);
  return a; }
constexpr int NCH5 = 4, NCH7 = 2;
struct EpiInPool {
  const Params* p; int pm, pn;
  DI void operator()(const AccT& acc, int wr, int wc, int fr, int fq) const {
    char* ws = p->ws; float* out = p->out; const int r0 = pm * 256, c0 = pn * 256;
    if (pn < 8) { float* U = (float*)(ws + W_U);
      EPI_LOOP({ const int tok = r0 + rl; const int col = c0 + cl; *(f32x4*)(U + (size_t)tok * DM + col) = v;
        if (tok < TP) { const int s = tok & 4095; if (s >= 4081) *(f32x4*)(out + O_POOLP + ((size_t)(tok >> 12) * 15 + (s - 4081)) * DM + col) = v; }
        else { const int s = (tok - TP) & 31; if (s >= 17) *(f32x4*)(out + O_POOLS + ((size_t)((tok - TP) >> 5) * 15 + (s - 17)) * DM + col) = v; } })
    } else { bf16_t* SG = (bf16_t*)(ws + W_SG);
      EPI_LOOP({ f32x4 s; s[0] = silu(v[0]); s[1] = silu(v[1]); s[2] = silu(v[2]); s[3] = silu(v[3]); *(u32x2*)(SG + (size_t)(r0 + rl) * DM + (c0 - 2048) + cl) = pack4(s); })
    }
  }
};
struct EpiGrp {
  bf16_t* MX; const bf16_t* SG; const float* scale; int r0; int c0;
  DI void operator()(const AccT& acc, int wr, int wc, int fr, int fq) const {
    EPI_LOOP({ const size_t idx = (size_t)(r0 + rl) * DM + c0 + cl; const f32x4 g = unpack4(*(const u32x2*)(SG + idx)); const f32x4 sc = *(const f32x4*)(scale + c0 + cl); *(u32x2*)(MX + idx) = pack4(v * sc * g); })
  }
};

template <int DQK, int DVW, int RG, int KSTR, int VSTR>
struct Flash {
  bf16x8 q[RG][DQK / 32];
  f32x4 o[DVW / 16][RG];
  f32x4 ol[RG];
  float m[RG];
  DI void init(const bf16_t* qp, size_t rgstride) {
#pragma unroll
    for (int rg = 0; rg < RG; ++rg) { m[rg] = 0.f; ol[rg] = (f32x4){0.f, 0.f, 0.f, 0.f};
#pragma unroll
      for (int ks = 0; ks < DQK / 32; ++ks) q[rg][ks] = *(const bf16x8*)(qp + rg * rgstride + ks * 32);
#pragma unroll
      for (int d = 0; d < DVW / 16; ++d) o[d][rg] = (f32x4){0.f, 0.f, 0.f, 0.f}; }
  }
  DI void tile(const LAS char* kt, const LAS char* vt, bool first, int nvalid) {
    const int lane = my_tid() & 63, fr = lane & 15, fq = lane >> 4;
    f32x4 s[4][RG];
#pragma unroll
    for (int kb = 0; kb < 4; ++kb)
#pragma unroll
      for (int rg = 0; rg < RG; ++rg) { const float nm = -m[rg]; s[kb][rg] = (f32x4){nm, nm, nm, nm}; }
    constexpr int KSB = (DVW > 128) ? 1 : 2;
#pragma unroll
    for (int ks0 = 0; ks0 < DQK / 32; ks0 += KSB) { bf16x8 kf[KSB][4];
#pragma unroll
      for (int kk = 0; kk < KSB; ++kk)
#pragma unroll
        for (int kb = 0; kb < 4; ++kb) kf[kk][kb] = *(const LAS bf16x8*)(kt + (kb * 16 + fr) * KSTR + ((ks0 + kk) * 32 + fq * 8) * 2);
#pragma unroll
      for (int kk = 0; kk < KSB; ++kk)
#pragma unroll
        for (int kb = 0; kb < 4; ++kb)
#pragma unroll
          for (int rg = 0; rg < RG; ++rg) s[kb][rg] = __builtin_amdgcn_mfma_f32_16x16x32_bf16(kf[kk][kb], q[rg][ks0 + kk], s[kb][rg], 0, 0, 0); }
    if (nvalid < 64) {
#pragma unroll
      for (int kb = 0; kb < 4; ++kb)
#pragma unroll
        for (int j = 0; j < 4; ++j) if (kb * 16 + fq * 4 + j >= nvalid) {
#pragma unroll
          for (int rg = 0; rg < RG; ++rg) s[kb][rg][j] = -1e30f; }
    }
    bf16x8 pf[2][RG];
#pragma unroll
    for (int rg = 0; rg < RG; ++rg) {
      float mx = s[0][rg][0];
#pragma unroll
      for (int kb = 0; kb < 4; ++kb)
#pragma unroll
        for (int j = 0; j < 4; ++j) mx = fmaxf(mx, s[kb][rg][j]);
      mx = quad_max(mx);
      if (first || !__all(mx <= 11.5f)) {
        const float dm = first ? mx : fmaxf(mx, 0.f);
        if (!first) { const float alpha = __builtin_amdgcn_exp2f(-dm);
#pragma unroll
          for (int d = 0; d < DVW / 16; ++d) o[d][rg] *= alpha;
          ol[rg] *= alpha; }
        m[rg] += dm;
#pragma unroll
        for (int kb = 0; kb < 4; ++kb) s[kb][rg] -= dm; }
#pragma unroll
      for (int kb = 0; kb < 4; ++kb)
#pragma unroll
        for (int j = 0; j < 4; ++j) s[kb][rg][j] = __builtin_amdgcn_exp2f(s[kb][rg][j]);
#pragma unroll
      for (int t = 0; t < 2; ++t) { u32x4 w; w.x = cvtpk(s[2 * t][rg][0], s[2 * t][rg][1]); w.y = cvtpk(s[2 * t][rg][2], s[2 * t][rg][3]);
        w.z = cvtpk(s[2 * t + 1][rg][0], s[2 * t + 1][rg][1]); w.w = cvtpk(s[2 * t + 1][rg][2], s[2 * t + 1][rg][3]); pf[t][rg] = __builtin_bit_cast(bf16x8, w); }
    }
    { const u32x4 o1 = {0x3F803F80u, 0x3F803F80u, 0x3F803F80u, 0x3F803F80u}; const bf16x8 ones = __builtin_bit_cast(bf16x8, o1);
#pragma unroll
      for (int t = 0; t < 2; ++t)
#pragma unroll
        for (int rg = 0; rg < RG; ++rg) ol[rg] = __builtin_amdgcn_mfma_f32_16x16x32_bf16(ones, pf[t][rg], ol[rg], 0, 0, 0); }
    const LAS char* vb = vt + (fq * 4 + (fr >> 2)) * VSTR + (fr & 3) * 8;
    constexpr int DG = (DVW > 128) ? 2 : ((DVW / 16) < 4 ? (DVW / 16) : 4);
#pragma unroll
    for (int d0 = 0; d0 < DVW / 16; d0 += DG) { bf16x8 vf[DG][2];
#pragma unroll
      for (int dd = 0; dd < DG; ++dd)
#pragma unroll
        for (int t = 0; t < 2; ++t) {
          const s16x4 lo = __builtin_amdgcn_ds_read_tr16_b64_v4i16((LAS s16x4*)(vb + (t * 32) * VSTR + (d0 + dd) * 32));
          const s16x4 hi = __builtin_amdgcn_ds_read_tr16_b64_v4i16((LAS s16x4*)(vb + (t * 32 + 16) * VSTR + (d0 + dd) * 32));
          vf[dd][t] = __builtin_shufflevector(lo, hi, 0, 1, 2, 3, 4, 5, 6, 7); }
#pragma unroll
      for (int t = 0; t < 2; ++t)
#pragma unroll
        for (int dd = 0; dd < DG; ++dd)
#pragma unroll
          for (int rg = 0; rg < RG; ++rg) o[d0 + dd][rg] = __builtin_amdgcn_mfma_f32_16x16x32_bf16(vf[dd][t], pf[t][rg], o[d0 + dd][rg], 0, 0, 0); }
  }
  DI float lsum(int rg) const { return ol[rg][0]; }
};

DI void dma16(const void* g, LAS char* ldsdst) { __builtin_amdgcn_global_load_lds((const unsigned*)g, (LAS unsigned*)ldsdst, 16, 0, 0); }

DI void unit_pd(const Params& p, LAS char* lds, int b, int h, int map, int qb) {
  constexpr int KSTR = 144, VSTR = 288, VOFF = 128 * KSTR, BUF = VOFF + 128 * VSTR;
  char* ws = p.ws; const bf16_t* QA = (const bf16_t*)(ws + W_QA);
  const int tid = my_tid(), wid = __builtin_amdgcn_readfirstlane(tid >> 6), lane = tid & 63, fr = lane & 15, fq = lane >> 4;
  const int tok0 = b * SEQ + qb * 256 + wid * 32;
  Flash<64, 128, 2, KSTR, VSTR> F;
  F.init(QA + (size_t)(tok0 + fr) * 1024 + h * 128 + map * 64 + fq * 8, (size_t)16 * 1024);
  const int NT2 = 2 * qb + 2, ntw = 4 * qb + (wid >> 1) + 1;
  unsigned goff[7];
#pragma unroll
  for (int k = 0; k < 7; ++k) { const int i = wid + 8 * k; const int slot = i * 64 + lane; goff[k] = 0u;
    if (i < 18) { const int r = slot / 9, c = slot - r * 9; goff[k] = (unsigned)(W_KA + ((size_t)(b * SEQ + r) * 1024 + h * 128 + map * 64 + (c < 8 ? c : 0) * 8) * 2); }
    else if (i < 54) { const int sl = slot - 1152; const int r = sl / 18, c = sl - r * 18; goff[k] = (unsigned)(W_VA + ((size_t)(b * SEQ + r) * 1024 + h * 128 + (c < 16 ? c : 0) * 8) * 2); } }
  auto issue = [&](int j, int buf) {
    LAS char* dst = lds + buf * BUF;
#pragma unroll
    for (int k = 0; k < 7; ++k) { const int i = wid + 8 * k; if (i < 54) dma16(ws + goff[k] + (size_t)j * (128 * 1024 * 2), dst + i * 1024); }
  };
  issue(0, 0); asm volatile("s_waitcnt vmcnt(0)" ::: "memory"); __syncthreads();
  for (int j = 0; j < NT2; ++j) { LAS char* tb = lds + (j & 1) * BUF;
    if (j + 1 < NT2) issue(j + 1, (j + 1) & 1);
    if (2 * j < ntw) F.tile(tb, tb + VOFF, j == 0, 64);
    if (2 * j + 1 < ntw) F.tile(tb + 64 * KSTR, tb + VOFF + 64 * VSTR, false, 64);
    asm volatile("s_waitcnt vmcnt(0)" ::: "memory"); __syncthreads();
  }
  bf16_t* OA = (bf16_t*)(ws + W_OA);
#pragma unroll
  for (int rg = 0; rg < 2; ++rg) { const float inv = 1.f / F.lsum(rg); const int tok = tok0 + rg * 16 + fr;
    bf16_t* o = OA + (((size_t)tok * 8 + h) * 2 + map) * 128 + fq * 4;
#pragma unroll
    for (int d = 0; d < 8; ++d) *(u32x2*)(o + d * 16) = pack4(F.o[d][rg] * inv); }
  __builtin_amdgcn_s_setprio(0);
}
DI void unit_pm(const Params& p, LAS char* lds, int b, int h, int qb) {
  constexpr int KSTR = 400, VSTR = 288, VOFF = 64 * KSTR, BUF = VOFF + 64 * VSTR;
  char* ws = p.ws; const bf16_t* QM = (const bf16_t*)(ws + W_QM); const bf16_t* KM = (const bf16_t*)(ws + W_KM); const bf16_t* VM = (const bf16_t*)(ws + W_VM); const bf16_t* KPE = (const bf16_t*)(ws + W_KPE);
  const int tid = my_tid(), wid = __builtin_amdgcn_readfirstlane(tid >> 6), lane = tid & 63, fr = lane & 15, fq = lane >> 4;
  const int tok0 = b * SEQ + qb * 256 + wid * 32;
  Flash<192, 128, 2, KSTR, VSTR> F;
  F.init(QM + (size_t)(tok0 + fr) * 1536 + h * 192 + fq * 8, (size_t)16 * 1536);
  const int NT = 4 * qb + 4, ntw = 4 * qb + (wid >> 1) + 1;
  const bf16_t* kbase = KM + (size_t)b * SEQ * 1024 + h * 128; const bf16_t* vbase = VM + (size_t)b * SEQ * 1024 + h * 128; const bf16_t* pbase = KPE + (size_t)b * SEQ * 64;
  unsigned goff[6], gstep[6];
#pragma unroll
  for (int k = 0; k < 6; ++k) { const int i = wid + 8 * k; const int slot = i * 64 + lane; goff[k] = 0u; gstep[k] = 64u * 1024u * 2u;
    if (i < 25) { const int r = slot / 25, c = slot - r * 25;
      if (c < 16) goff[k] = (unsigned)(W_KM + ((size_t)(b * SEQ + r) * 1024 + h * 128 + c * 8) * 2);
      else { goff[k] = (unsigned)(W_KPE + ((size_t)(b * SEQ + r) * 64 + (c < 24 ? c - 16 : 0) * 8) * 2); gstep[k] = 64u * 64u * 2u; } }
    else if (i < 43) { const int sl = slot - 1600; const int r = sl / 18, c = sl - r * 18; goff[k] = (unsigned)(W_VM + ((size_t)(b * SEQ + r) * 1024 + h * 128 + (c < 16 ? c : 0) * 8) * 2); } }
  auto issue = [&](int j, int buf) {
    LAS char* dst = lds + buf * BUF;
#pragma unroll
    for (int k = 0; k < 6; ++k) { const int i = wid + 8 * k; if (i < 43) dma16(ws + goff[k] + (size_t)j * gstep[k], dst + i * 1024); }
  };
  issue(0, 0); asm volatile("s_waitcnt vmcnt(0)" ::: "memory"); __syncthreads();
  for (int j = 0; j < NT; ++j) {
    if (j + 1 < NT) issue(j + 1, (j + 1) & 1);
    if (j < ntw) F.tile(lds + (j & 1) * BUF, lds + (j & 1) * BUF + VOFF, j == 0, 64);
    asm volatile("s_waitcnt vmcnt(0)" ::: "memory"); __syncthreads();
  }
  bf16_t* O = (bf16_t*)(ws + W_O); const bf16_t* SG = (const bf16_t*)(ws + W_SG);
#pragma unroll
  for (int rg = 0; rg < 2; ++rg) { const float inv = 1.f / F.lsum(rg); const int tok = tok0 + rg * 16 + fr;
    const size_t base = (size_t)tok * 2048 + 1024 + h * 128 + fq * 4;
#pragma unroll
    for (int d = 0; d < 8; ++d) { const f32x4 g = unpack4(*(const u32x2*)(SG + base + d * 16)); *(u32x2*)(O + base + d * 16) = pack4(F.o[d][rg] * inv * g); } }
  __builtin_amdgcn_s_setprio(0);
}
DI void unit_sm(const Params& p, LAS char* lds, int b, int rh, int sp) {
  constexpr int KSTR = 1168, BUF = 64 * KSTR;
  char* ws = p.ws; const bf16_t* QS = (const bf16_t*)(ws + W_QS); const bf16_t* CC = (const bf16_t*)(ws + W_CC);
  const int tid = my_tid(), wid = __builtin_amdgcn_readfirstlane(tid >> 6), lane = tid & 63, fr = lane & 15, fq = lane >> 4;
  const int R = rh * 128 + wid * 16 + fr;
  Flash<576, 512, 1, KSTR, KSTR> F;
  F.init(QS + ((size_t)b * 256 + R) * 576 + fq * 8, 0);
  const int j0 = sp == 0 ? 0 : 1 + sp * 16, j1 = 17 + sp * 16;
  const bf16_t* cbase = CC + (size_t)b * 4160 * 576;
  auto issue = [&](int j, int buf) {
    LAS char* dst = lds + buf * BUF;
    for (int i = wid; i < 73; i += 8) { const int slot = i * 64 + lane; const int r = slot / 73, c = slot - r * 73;
      dma16(cbase + (size_t)(j * 64 + r) * 576 + (c < 72 ? c : 0) * 8, dst + i * 1024); }
  };
  issue(j0, 0); asm volatile("s_waitcnt vmcnt(0)" ::: "memory"); __syncthreads();
  for (int j = j0; j < j1; ++j) { const int bi = (j - j0) & 1;
    if (j + 1 < j1) issue(j + 1, bi ^ 1);
    F.tile(lds + bi * BUF, lds + bi * BUF, j == j0, j == 64 ? 32 : 64);
    asm volatile("s_waitcnt vmcnt(0)" ::: "memory"); __syncthreads();
  }
  float* OPM = (float*)(ws + W_OPM); float* MLM = (float*)(ws + W_MLM);
  const float lt = F.lsum(0); const float inv = 1.f / lt; const size_t ri = ((size_t)b * 256 + R) * 4 + sp;
  float* o = OPM + ri * 512 + fq * 4;
#pragma unroll
  for (int d = 0; d < 32; ++d) *(f32x4*)(o + d * 16) = F.o[d][0] * inv;
  if (fq == 0) *(f32x2*)(MLM + ri * 2) = (f32x2){F.m[0], lt};
  __builtin_amdgcn_s_setprio(0);
}
DI void unit_sd(const Params& p, LAS char* lds, int b, int h, int sp) {
  constexpr int STR = 272, VSTR2 = 288, VOFF = 64 * STR, BUF = VOFF + 64 * VSTR2;
  char* ws = p.ws; const bf16_t* QA = (const bf16_t*)(ws + W_QA); const bf16_t* KA = (const bf16_t*)(ws + W_KA); const bf16_t* VA = (const bf16_t*)(ws + W_VA);
  const float* CK = p.in[4]; const float* CV = p.in[5];
  const int tid = my_tid(), wid = __builtin_amdgcn_readfirstlane(tid >> 6), lane = tid & 63, fr = lane & 15, fq = lane >> 4;
  const int map = wid & 1, dvq = wid >> 1;
  const int tokq = TP + b * 32;
  Flash<64, 32, 2, STR, VSTR2> F;
  F.init(QA + (size_t)(tokq + fr) * 1024 + h * 128 + map * 64 + fq * 8, (size_t)16 * 1024);
  const int j0 = sp == 0 ? 0 : 33, j1 = sp == 0 ? 33 : 65;
  const int lr = tid >> 3, part = tid & 7;
  f32x4 rkA[4], rvA[4], rkB[4], rvB[4];
  auto issue = [&](int j, f32x4 (&rk)[4], f32x4 (&rv)[4]) {
    if (j < 64) { const size_t off = (((size_t)b * PAST + j * 64 + lr) * 8 + h) * 128 + part * 4;
#pragma unroll
      for (int i = 0; i < 4; ++i) { rk[i] = *(const f32x4*)(CK + off + i * 32); rv[i] = *(const f32x4*)(CV + off + i * 32); } }
    else if (lr < 32) { const size_t off = (size_t)(tokq + lr) * 1024 + h * 128 + part * 4;
#pragma unroll
      for (int i = 0; i < 4; ++i) { rk[i] = unpack4(*(const u32x2*)(KA + off + i * 32)); rv[i] = unpack4(*(const u32x2*)(VA + off + i * 32)); } }
    else {
#pragma unroll
      for (int i = 0; i < 4; ++i) { rk[i] = (f32x4){0.f, 0.f, 0.f, 0.f}; rv[i] = (f32x4){0.f, 0.f, 0.f, 0.f}; } }
  };
  auto commit = [&](int buf, const f32x4 (&rk)[4], const f32x4 (&rv)[4]) {
    LAS char* kd = lds + buf * BUF + lr * STR + part * 8; LAS char* vd = lds + buf * BUF + VOFF + lr * VSTR2 + part * 8;
#pragma unroll
    for (int i = 0; i < 4; ++i) { *(LAS u32x2*)(kd + i * 64) = pack4(rk[i]); *(LAS u32x2*)(vd + i * 64) = pack4(rv[i]); }
  };
  issue(j0, rkA, rvA); if (j0 + 1 < j1) issue(j0 + 1, rkB, rvB);
  commit(0, rkA, rvA); __syncthreads();
  for (int j = j0; j < j1; j += 2) {
    if (j + 2 < j1) issue(j + 2, rkA, rvA);
    F.tile(lds + map * 128, lds + VOFF + dvq * 64, j == j0, j == 64 ? 32 : 64);
    if (j + 1 < j1) commit(1, rkB, rvB);
    __syncthreads();
    if (j + 1 < j1) {
      if (j + 3 < j1) issue(j + 3, rkB, rvB);
      F.tile(lds + BUF + map * 128, lds + BUF + VOFF + dvq * 64, false, (j + 1) == 64 ? 32 : 64);
      if (j + 2 < j1) commit(0, rkA, rvA);
      __syncthreads();
    }
  }
  float* OPD = (float*)(ws + W_OPD); float* MLD = (float*)(ws + W_MLD);
#pragma unroll
  for (int rg = 0; rg < 2; ++rg) { const float lt = F.lsum(rg); const float inv = 1.f / lt;
    const size_t ri = ((((size_t)b * 8 + h) * 2 + map) * 2 + sp) * 32 + rg * 16 + fr;
    float* o = OPD + ri * 128 + dvq * 32 + fq * 4;
#pragma unroll
    for (int d = 0; d < 2; ++d) *(f32x4*)(o + d * 16) = F.o[d][rg] * inv;
    if (dvq == 0 && fq == 0) *(f32x2*)(MLD + ri * 2) = (f32x2){F.m[rg], lt}; }
  __builtin_amdgcn_s_setprio(0);
}

template <int LAYER>
DI void phase_norm(const Params& p, LAS char* lds) {
  char* ws = p.ws; const int tid = my_tid(), wid = tid >> 6, lane = tid & 63;
  LAS float* la = (LAS float*)lds; LAS float* lsh = la + 2048;
  const float* gn = p.in[9] + LAYER * DM; const float* bada = p.in[11] + LAYER * 6144;
  const float* MODP = (const float*)(ws + W_MODP); const float* MOD = (const float*)(ws + W_MOD); const float* X1 = (const float*)(ws + W_X1);
  bf16_t* H = (bf16_t*)(ws + W_H);
  const int per = (TT + (int)gridDim.x - 1) / (int)gridDim.x; const int rbeg = blockIdx.x * per, rend = rbeg + per < TT ? rbeg + per : TT;
  for (int tok0 = rbeg; tok0 < rend;) {
    const int b = tok_batch(tok0); const int bend = tok0 < TP ? ((tok0 >> 12) + 1) << 12 : TP + ((((tok0 - TP) >> 5) + 1) << 5); const int tok1 = bend < rend ? bend : rend;
    __syncthreads();
    for (int k = tid; k < 2048; k += 512) { float sh, sc;
      if (LAYER == 0) { sh = bada[k]; sc = bada[2048 + k];
        float a8[8], b8[8];
_Pragma("unroll") for (int ks = 0; ks < 8; ++ks) { const float* mp = MODP + (((size_t)ks * 2 + 0) * NB + b) * 6144; a8[ks] = mp[k]; b8[ks] = mp[2048 + k]; }
_Pragma("unroll") for (int ks = 0; ks < 8; ++ks) { sh += a8[ks]; sc += b8[ks]; } }
      else { const float* mp = MOD + ((size_t)1 * NB + b) * 6144; sh = mp[k]; sc = mp[2048 + k]; }
      la[k] = gn[k] * (1.f + sc); lsh[k] = sh; }
    __syncthreads();
    for (int tok = tok0 + wid; tok < tok1; tok += 8) {
      const float* xr = LAYER == 0 ? x_row(p, tok) : X1 + (size_t)tok * DM;
      f32x4 v[8]; float ss = 0.f;
      if (LAYER == 1 && tok >= TP) {
        const float* x0 = x_row(p, tok); const float* g0 = MOD + (size_t)b * 6144 + 4096; const float* PART = (const float*)(ws + W_OA); float* X1w = (float*)(ws + W_X1) + (size_t)tok * DM;
#pragma unroll
        for (int i = 0; i < 8; ++i) { const int k = (i * 64 + lane) * 4; const f32x4 y = *(const f32x4*)(x0 + k) + *(const f32x4*)(g0 + k) * part_sum<NCH5>(PART, tok - TP, k); *(f32x4*)(X1w + k) = y; v[i] = y; } }
      else {
#pragma unroll
        for (int i = 0; i < 8; ++i) v[i] = *(const f32x4*)(xr + (i * 64 + lane) * 4); }
#pragma unroll
      for (int i = 0; i < 8; ++i) ss += v[i][0] * v[i][0] + v[i][1] * v[i][1] + v[i][2] * v[i][2] + v[i][3] * v[i][3];
      ss = wave_sum(ss); const float rstd = rsqrtf(ss * (1.f / 2048.f) + 1e-6f);
#pragma unroll
      for (int i = 0; i < 8; ++i) { const int k = (i * 64 + lane) * 4; const f32x4 a = *(const LAS f32x4*)(la + k); const f32x4 s = *(const LAS f32x4*)(lsh + k);
        *(u32x2*)(H + (size_t)tok * DM + k) = pack4(v[i] * rstd * a + s); } }
    tok0 = tok1;
  }
}

DI void transpose_items(const Params& p, LAS char* lds, int first, int last, int worker, int nworkers) {
  char* ws = p.ws; const int tid = my_tid(), wid = tid >> 6, lane = tid & 63;
  LAS float* tile = (LAS float*)lds + wid * (64 * 65);
  for (int it = first + worker * 8 + wid; it < last; it += nworkers * 8) {
    const float* src; bf16_t* dst; int N, Kd, nn, t; bool perm = false;
    if (it < 3104) { t = it; src = p.in[12]; N = IN_ATT; dst = (bf16_t*)(ws + W_WINT); Kd = 2048; nn = 97; }
    else if (it < 4128) { t = it - 3104; src = p.in[13]; N = 2048; dst = (bf16_t*)(ws + W_WOUTT); Kd = 2048; nn = 32; }
    else if (it < 4256) { t = it - 4128; src = p.in[20]; N = 1024; dst = (bf16_t*)(ws + W_WQT); Kd = 512; nn = 16; }
    else if (it < 4320) { t = it - 4256; src = p.in[21]; N = 512; dst = (bf16_t*)(ws + W_WQT) + (size_t)1024 * 512; Kd = 512; nn = 8; perm = true; }
    else if (it < 4448) { t = it - 4320; src = p.in[22]; N = 1024; dst = (bf16_t*)(ws + W_WKVT); Kd = 512; nn = 16; }
    else if (it < 4576) { t = it - 4448; src = p.in[23]; N = 1024; dst = (bf16_t*)(ws + W_WKVT) + (size_t)1024 * 512; Kd = 512; nn = 16; }
    else if (it < 6624) { t = it - 4576; src = p.in[25]; N = 4096; dst = (bf16_t*)(ws + W_WINPT); Kd = 2048; nn = 64; }
    else if (it < 6880) { t = it - 6624; const int g = t >> 6; t &= 63; src = p.in[26] + (size_t)g * 512 * 512; N = 512; dst = (bf16_t*)(ws + W_WGRPT) + (size_t)g * 512 * 512; Kd = 512; nn = 8; }
    else { t = it - 6880; src = p.in[28]; N = 2048; dst = (bf16_t*)(ws + W_WOUTPT); Kd = 2048; nn = 32; }
    const int n0 = (t % nn) * 64, k0 = (t / nn) * 64;
    if (it < 3104 && n0 == 4096) perm = true;
    f32x4 v[16];
#pragma unroll
    for (int i = 0; i < 16; ++i) v[i] = *(const f32x4*)(src + (size_t)(k0 + i * 4 + (lane >> 4)) * N + n0 + (lane & 15) * 4);
#pragma unroll
    for (int i = 0; i < 16; ++i) { LAS float* tp = tile + (i * 4 + (lane >> 4)) * 65 + (lane & 15) * 4; tp[0] = v[i][0]; tp[1] = v[i][1]; tp[2] = v[i][2]; tp[3] = v[i][3]; }
    asm volatile("s_waitcnt lgkmcnt(0)" ::: "memory");
    const int kc = (lane & 7) * 8;
#pragma unroll
    for (int jj = 0; jj < 8; ++jj) { const int n = jj * 8 + (lane >> 3); const int cn = perm ? ((n >> 1) + 32 * (n & 1)) : n;
      u32x4 w; w.x = cvtpk(tile[(kc + 0) * 65 + cn], tile[(kc + 1) * 65 + cn]); w.y = cvtpk(tile[(kc + 2) * 65 + cn], tile[(kc + 3) * 65 + cn]);
      w.z = cvtpk(tile[(kc + 4) * 65 + cn], tile[(kc + 5) * 65 + cn]); w.w = cvtpk(tile[(kc + 6) * 65 + cn], tile[(kc + 7) * 65 + cn]);
      *(u32x4*)(dst + (size_t)(n0 + n) * Kd + k0 + kc) = w; }
    asm volatile("s_waitcnt lgkmcnt(0)" ::: "memory");
  }
}
DI void convert_cache(const Params& p, size_t wt, size_t nwt) {
  char* ws = p.ws; bf16_t* CC = (bf16_t*)(ws + W_CC); const float* cckv = p.in[6]; const float* ckpe = p.in[7];
  for (size_t i = wt; i < (size_t)NSB * 4096 * 72; i += nwt) { const size_t row = i / 72; const int c = (int)(i - row * 72); const size_t b = row >> 12, t = row & 4095;
    const float* s = c < 64 ? cckv + row * 512 + c * 8 : ckpe + row * 64 + (c - 64) * 8; const f32x4 v0 = *(const f32x4*)s, v1 = *(const f32x4*)(s + 4);
    u32x4 w; w.x = cvtpk(v0[0], v0[1]); w.y = cvtpk(v0[2], v0[3]); w.z = cvtpk(v1[0], v1[1]); w.w = cvtpk(v1[2], v1[3]); *(u32x4*)(CC + (b * 4160 + t) * 576 + c * 8) = w; }
  for (size_t i = wt; i < (size_t)NSB * 32 * 72; i += nwt) { const size_t row = i / 72; const int c = (int)(i - row * 72); const size_t b = row >> 5, t = 4128 + (row & 31);
    *(u32x4*)(CC + (b * 4160 + t) * 576 + c * 8) = (u32x4){0u, 0u, 0u, 0u}; }
}

__global__ void __launch_bounds__(512, 2) mega(Params p) {
  extern __shared__ __attribute__((aligned(16))) char shm[];
  __shared__ int s_item;
  __shared__ uint4 xb_words;
  LAS char* lds = (LAS char*)shm;
  cg::grid_group grid = cg::this_grid();
  char* ws = p.ws; float* out = p.out;
  const int nblk = gridDim.x, bid = blockIdx.x;
  unsigned* xbar = (unsigned*)(ws + W_BAR); volatile LAS unsigned* xst = (volatile LAS unsigned*)&xb_words;
  if (threadIdx.x == 0) xb_words = make_uint4(0u, 0u, 0u, 0u);
  __syncthreads();
#define PH_VARS const int tid = my_tid(), wid = tid >> 6, lane = tid & 63; const size_t gtid = (size_t)bid * 512 + tid, gthreads = (size_t)nblk * 512; (void)wid; (void)lane; (void)gtid; (void)gthreads;

  for (int rep = 0; rep < REP_P0; ++rep) {
    PH_VARS
    if (bid == 0 && tid < 8) ((int*)(ws + W_CNT))[tid] = 0;
    if (bid == 0 && rep == 0) for (int i = tid; i < XCD_BAR_WORDS; i += 512) xbar[i] = 0u;
    { LAS float* cond = (LAS float*)lds; float* MODP = (float*)(ws + W_MODP);
      for (int it = bid; it < 2 * 24 * 8; it += nblk) { const int l = it / 192, rem = it % 192, nc = rem >> 3, ks = rem & 7;
        __syncthreads();
        for (int i = tid; i < NB * 256; i += 512) { const int b = i >> 8, kk = i & 255; const float c = b < 2 ? p.in[2][b * DM + ks * 256 + kk] : p.in[3][(b - 2) * DM + ks * 256 + kk]; cond[i] = silu(c); }
        __syncthreads();
        const int ksub = lane >> 3, n = nc * 256 + wid * 32 + (lane & 7) * 4;
        const float* w = p.in[10] + ((size_t)l * DM + ks * 256 + ksub) * 6144 + n;
        f32x4 acc[NB];
#pragma unroll
        for (int b = 0; b < NB; ++b) acc[b] = (f32x4){0.f, 0.f, 0.f, 0.f};
        for (int i8 = 0; i8 < 32; i8 += 8) { f32x4 wv[8];
#pragma unroll
          for (int j = 0; j < 8; ++j) wv[j] = *(const f32x4*)(w + (size_t)(i8 + j) * 8 * 6144);
#pragma unroll
          for (int j = 0; j < 8; ++j)
#pragma unroll
            for (int b = 0; b < NB; ++b) acc[b] += wv[j] * cond[b * 256 + ksub + (i8 + j) * 8]; }
#pragma unroll
        for (int b = 0; b < NB; ++b)
#pragma unroll
          for (int e = 0; e < 4; ++e) { float v = acc[b][e]; v += __shfl_xor(v, 8); v += __shfl_xor(v, 16); v += __shfl_xor(v, 32); acc[b][e] = v; }
        if (lane < 8) {
#pragma unroll
          for (int b = 0; b < NB; ++b) *(f32x4*)(MODP + (((size_t)ks * 2 + l) * NB + b) * 6144 + n) = acc[b]; }
      }
      __syncthreads();
    }
    transpose_items(p, lds, 0, 4576, bid, nblk);
    __syncthreads();
    { u32x4 z = {0u, 0u, 0u, 0u}; u32x4* a = (u32x4*)((bf16_t*)(ws + W_WINT) + (size_t)IN_ATT * 2048); for (size_t i = gtid; i < (size_t)192 * 2048 / 8; i += gthreads) a[i] = z;
      u32x4* c = (u32x4*)((bf16_t*)(ws + W_WKVT) + (size_t)2048 * 512); for (size_t i = gtid; i < (size_t)256 * 512 / 8; i += gthreads) c[i] = z; }
    { bf16_t* WP = (bf16_t*)(ws + W_WUKP); const float* wuk = p.in[22];
      for (size_t i = gtid; i < (size_t)8 * 512 * 256 / 4; i += gthreads) { const int e = (int)(i * 4); const int h = e >> 17, c = (e >> 8) & 511, kk = e & 255;
        f32x4 v = *(const f32x4*)(wuk + (size_t)c * 1024 + (h & ~1) * 128 + kk); if ((kk >> 7) != (h & 1)) v = (f32x4){0.f, 0.f, 0.f, 0.f}; *(u32x2*)(WP + e) = pack4(v); } }
    { float* ROPE = (float*)(ws + W_ROPE);
      for (size_t i = gtid; i < (size_t)4128 * 32; i += gthreads) { const int pos = (int)(i >> 5), r = (int)(i & 31);
        const double inv = exp2(-(double)r * (13.287712379549449 / 32.0)); double tr = (double)pos * inv * 0.15915494309189535; tr -= rint(tr);
        const float a = (float)(tr * 6.283185307179586); *(f32x2*)(ROPE + i * 2) = (f32x2){cosf(a), sinf(a)}; } }
  }
  grid.sync();
  xcd_barrier_post(xbar);
  for (int rep_e = 0; rep_e < REP_P1; ++rep_e) {
    PH_VARS
    float* MOD = (float*)(ws + W_MOD); const float* MODP = (const float*)(ws + W_MODP);
    for (size_t i = gtid; i < (size_t)2 * NB * 6144; i += gthreads) { const int l = (int)(i / (NB * 6144)); const int rem = (int)(i % (NB * 6144)); const int b = rem / 6144, n = rem % 6144;
      float s = p.in[11][l * 6144 + n]; float a8[8];
_Pragma("unroll") for (int ks = 0; ks < 8; ++ks) a8[ks] = MODP[(((size_t)ks * 2 + l) * NB + b) * 6144 + n];
_Pragma("unroll") for (int ks = 0; ks < 8; ++ks) s += a8[ks]; MOD[i] = s; }
    phase_norm<0>(p, lds);
  }
  xcd_barrier(xbar, xst);
  for (int rep = 0; rep < REP_G; ++rep) for (int t = bid; t < 34 * 25; t += nblk) { int pn, pm; tile_map(t, 34, 25, pm, pn); EpiInAtt e{&p, pm, pn};
    const bf16_t* nA = nullptr; const bf16_t* nB = nullptr;
    if (t + nblk < 34 * 25) { int qn, qm; tile_map(t + nblk, 34, 25, qm, qn); nA = (const bf16_t*)(ws + W_H) + (size_t)qm * 256 * 2048; nB = (const bf16_t*)(ws + W_WINT) + (size_t)qn * 256 * 2048; }
    gemm_tile(lds, (const bf16_t*)(ws + W_H) + (size_t)pm * 256 * 2048, 2048, (const bf16_t*)(ws + W_WINT) + (size_t)pn * 256 * 2048, 2048, 2048, e, t != bid, nA, nB); }
  {
    const int nlast = (34 * 25) % nblk; const int nw = nblk - nlast;
    if (nlast > 0 && nw > 0) { if (bid >= nlast) { transpose_items(p, lds, 4576, 7904, bid - nlast, nw); convert_cache(p, (size_t)(bid - nlast) * 512 + my_tid(), (size_t)nw * 512); } }
    else { transpose_items(p, lds, 4576, 7904, bid, nblk); convert_cache(p, (size_t)bid * 512 + my_tid(), (size_t)nblk * 512); } }
  xcd_barrier(xbar, xst);
  for (int rep_e = 0; rep_e < REP_P2B; ++rep_e) {
    PH_VARS
    const float* CQ = (const float*)(ws + W_CQ); const float* CKVR = (const float*)(ws + W_CKVR); bf16_t* CQN = (bf16_t*)(ws + W_CQN); bf16_t* CKVN = (bf16_t*)(ws + W_CKVN); bf16_t* CC = (bf16_t*)(ws + W_CC);
    const float* gqa = p.in[19]; const float* gkva = p.in[24];
    for (int tok = bid * 8 + wid; tok < TT; tok += nblk * 8) {
      { f32x4 v[2]; float ss = 0.f;
#pragma unroll
        for (int i = 0; i < 2; ++i) { v[i] = *(const f32x4*)(CQ + (size_t)tok * 512 + (i * 64 + lane) * 4); ss += v[i][0] * v[i][0] + v[i][1] * v[i][1] + v[i][2] * v[i][2] + v[i][3] * v[i][3]; }
        ss = wave_sum(ss); const float rstd = rsqrtf(ss * (1.f / 512.f) + 1e-6f);
#pragma unroll
        for (int i = 0; i < 2; ++i) { const int k = (i * 64 + lane) * 4; *(u32x2*)(CQN + (size_t)tok * 512 + k) = pack4(v[i] * rstd * *(const f32x4*)(gqa + k)); } }
      { f32x4 v[2]; float ss = 0.f;
#pragma unroll
        for (int i = 0; i < 2; ++i) { v[i] = *(const f32x4*)(CKVR + (size_t)tok * 512 + (i * 64 + lane) * 4); ss += v[i][0] * v[i][0] + v[i][1] * v[i][1] + v[i][2] * v[i][2] + v[i][3] * v[i][3]; }
        ss = wave_sum(ss); const float rstd = rsqrtf(ss * (1.f / 512.f) + 1e-6f);
        float* o = tok < TP ? out + O_CKVP + (size_t)tok * 512 : out + O_CKVS + (size_t)(tok - TP) * 512;
#pragma unroll
        for (int i = 0; i < 2; ++i) { const int k = (i * 64 + lane) * 4; const f32x4 y = v[i] * rstd * *(const f32x4*)(gkva + k); *(f32x4*)(o + k) = y; const u32x2 w = pack4(y);
          *(u32x2*)(CKVN + (size_t)tok * 512 + k) = w;
          if (tok >= TP) *(u32x2*)(CC + ((size_t)((tok - TP) >> 5) * 4160 + 4096 + ((tok - TP) & 31)) * 576 + k) = w; } }
    }
  }
  xcd_barrier(xbar, xst);
  for (int rep = 0; rep < REP_G; ++rep) {
    for (int t = bid; t < 256; t += nblk) { int pn, pm; tile_map(t, 32, 8, pm, pn); EpiBf16 e{(bf16_t*)(ws + (pn < 4 ? W_KM : W_VM)), 1024, pm * 256, (pn & 3) * 256};
      gemm_tile(lds, (const bf16_t*)(ws + W_CKVN) + (size_t)pm * 256 * 512, 512, (const bf16_t*)(ws + W_WKVT) + (size_t)pn * 256 * 512, 512, 512, e); }
    for (int t = nblk - 1 - bid; t < 204; t += nblk) { int pn, pm; tile_map(t, 34, 6, pm, pn); EpiQ e{&p, pm, pn};
      gemm_tile(lds, (const bf16_t*)(ws + W_CQN) + (size_t)pm * 256 * 512, 512, (const bf16_t*)(ws + W_WQT) + (size_t)pn * 256 * 512, 512, 512, e); }
  }
  xcd_barrier(xbar, xst);
  for (int rep = 0; rep < REP_P4; ++rep) {
    PH_VARS
    int* cnt = (int*)(ws + W_CNT) + rep;
    for (;;) {
      __syncthreads();
      if (tid == 0) s_item = atomicAdd(cnt, 1);
      __syncthreads();
      int it = s_item;
      if (it >= 1184) break;
      unsigned* qflag = (unsigned*)(ws + W_CNT) + 4;
      if (it < 32) {
        const int h = it >> 2, pm = (it >> 1) & 1, pn = it & 1; EpiQlat e{(bf16_t*)(ws + W_QS), h, pm * 256, pn * 256};
        gemm_tile(lds, (const bf16_t*)(ws + W_QNS) + (size_t)pm * 256 * 1024 + (h >> 1) * 256, 1024, (const bf16_t*)(ws + W_WUKP) + ((size_t)h * 512 + pn * 256) * 256, 256, 256, e);
        flag_publish(qflag); continue; }
      it -= 32;
      bool is_sd = false; int sdi = 0;
      if (it < 896) { const int g7 = it / 7, p7 = it - g7 * 7; is_sd = (p7 == 2) || (p7 == 5); sdi = 2 * g7 + (p7 == 5 ? 1 : 0); it -= 2 * g7 + (p7 > 2 ? 1 : 0) + (p7 > 5 ? 1 : 0); }
      else it -= 256;
      if (is_sd) { for (int r = 0; r < REP_SD; ++r) unit_sd(p, lds, sdi >> 4, (sdi >> 1) & 7, sdi & 1); }
      else if (it < 128) { const int qb = 15 - (it >> 4), bh = it & 15; for (int r = 0; r < REP_PM; ++r) unit_pm(p, lds, bh >> 3, bh & 7, qb); }
      else if (it < 256) { it -= 128; flag_wait(qflag, 32u); for (int r = 0; r < REP_SM; ++r) unit_sm(p, lds, it >> 3, (it >> 2) & 1, it & 3); }
      else if (it < 512) { it -= 256; const int qb = 15 - (it >> 5), r = it & 31; for (int r2 = 0; r2 < REP_PD; ++r2) unit_pd(p, lds, r >> 4, (r >> 1) & 7, r & 1, qb); }
      else if (it < 640) { it -= 512; const int qb = 7 - (it >> 4), bh = it & 15; for (int r = 0; r < REP_PM; ++r) unit_pm(p, lds, bh >> 3, bh & 7, qb); }
      else { it -= 640; const int qb = 7 - (it >> 5), r = it & 31; for (int r2 = 0; r2 < REP_PD; ++r2) unit_pd(p, lds, r >> 4, (r >> 1) & 7, r & 1, qb); }
    }
  }
  xcd_barrier(xbar, xst);
  for (int rep_e = 0; rep_e < REP_P4B; ++rep_e) {
    PH_VARS
    float dq1 = wave_sum(p.in[14][lane] * p.in[15][lane]), dq2 = wave_sum(p.in[16][lane] * p.in[17][lane]);
    const float lam = __expf(dq1) - __expf(dq2) + 0.2f;
    const bf16_t* OA = (const bf16_t*)(ws + W_OA); const bf16_t* SG = (const bf16_t*)(ws + W_SG); bf16_t* O = (bf16_t*)(ws + W_O); const float* gs = p.in[18];
    const int sub = tid >> 5, e = (tid & 31) * 4;
    const f32x4 g4 = *(const f32x4*)(gs + e) * 0.8f;
    for (int pi = bid * 16 + sub; pi < TP * 8; pi += nblk * 16) { const int tok = pi >> 3, h = pi & 7;
      const f32x4 a = unpack4(*(const u32x2*)(OA + (((size_t)tok * 8 + h) * 2) * 128 + e)), b2 = unpack4(*(const u32x2*)(OA + (((size_t)tok * 8 + h) * 2 + 1) * 128 + e));
      const f32x4 o = a - lam * b2; float ss = o[0] * o[0] + o[1] * o[1] + o[2] * o[2] + o[3] * o[3];
      for (int s = 1; s <= 16; s <<= 1) ss += __shfl_xor(ss, s);
      const float rstd = rsqrtf(ss * (1.f / 128.f) + 1e-5f); const size_t idx = (size_t)tok * 2048 + h * 128 + e;
      *(u32x2*)(O + idx) = pack4(o * rstd * g4 * unpack4(*(const u32x2*)(SG + idx))); }
    { const float* OPD = (const float*)(ws + W_OPD); const float* MLD = (const float*)(ws + W_MLD);
      for (int pi = bid * 16 + sub; pi < NSB * 8 * 32; pi += nblk * 16) { const int b = pi >> 8, h = (pi >> 5) & 7, s = pi & 31;
        f32x4 om[2];
#pragma unroll
        for (int map = 0; map < 2; ++map) { const size_t r0 = ((((size_t)b * 8 + h) * 2 + map) * 2 + 0) * 32 + s, r1 = r0 + 32;
          const f32x2 ml0 = *(const f32x2*)(MLD + r0 * 2), ml1 = *(const f32x2*)(MLD + r1 * 2); const float M = fmaxf(ml0[0], ml1[0]);
          const float w0 = ml0[1] * __builtin_amdgcn_exp2f(ml0[0] - M), w1 = ml1[1] * __builtin_amdgcn_exp2f(ml1[0] - M); const float inv = 1.f / (w0 + w1);
          om[map] = (*(const f32x4*)(OPD + r0 * 128 + e) * w0 + *(const f32x4*)(OPD + r1 * 128 + e) * w1) * inv; }
        const f32x4 o = om[0] - lam * om[1]; float ss = o[0] * o[0] + o[1] * o[1] + o[2] * o[2] + o[3] * o[3];
        for (int t = 1; t <= 16; t <<= 1) ss += __shfl_xor(ss, t);
        const float rstd = rsqrtf(ss * (1.f / 128.f) + 1e-5f); const size_t idx = (size_t)(TP + b * 32 + s) * 2048 + h * 128 + e;
        *(u32x2*)(O + idx) = pack4(o * rstd * g4 * unpack4(*(const u32x2*)(SG + idx))); } }
    { const float* OPM = (const float*)(ws + W_OPM); const float* MLM = (const float*)(ws + W_MLM); bf16_t* OLAT = (bf16_t*)(ws + W_OLAT);
      const int sub4 = tid >> 7, c = (tid & 127) * 4;
      for (int ri = bid * 4 + sub4; ri < NSB * 256; ri += nblk * 4) { const int b = ri >> 8, R = ri & 255, h = R >> 5, s = R & 31;
        float mm[4], ll[4]; float M = -1e30f;
#pragma unroll
        for (int k = 0; k < 4; ++k) { const f32x2 ml = *(const f32x2*)(MLM + ((size_t)ri * 4 + k) * 2); mm[k] = ml[0]; ll[k] = ml[1]; M = fmaxf(M, ml[0]); }
        f32x4 acc = {0.f, 0.f, 0.f, 0.f}; float wsum = 0.f;
#pragma unroll
        for (int k = 0; k < 4; ++k) { const float w = ll[k] * __builtin_amdgcn_exp2f(mm[k] - M); wsum += w; acc += *(const f32x4*)(OPM + ((size_t)ri * 4 + k) * 512 + c) * w; }
        *(u32x2*)(OLAT + (((size_t)b * 32 + s) * 8 + h) * 512 + c) = pack4(acc * (1.f / wsum)); } }
  }
  xcd_barrier(xbar, xst);
  { unsigned* oflag = (unsigned*)(ws + W_CNT) + 5;
    if (bid >= nblk - 16) { const int u16 = bid - (nblk - 16); const int h = u16 >> 1, pm = u16 & 1; EpiOb e{
     (bf16_t*)(ws + W_O), (const bf16_t*)(ws + W_SG), h, pm * 256};
      gemm_tile(lds, (const bf16_t*)(ws + W_OLAT) + (size_t)pm * 256 * 4096 + h * 512, 4096, (const bf16_t*)(ws + W_WKVT) + (size_t)(1024 + h * 128) * 512, 512, 512, e);
      flag_publish(oflag); }
    for (int rep = 0; rep < REP_G; ++rep) for (int t = bid; t < 256 + 16 * NCH5; t += nblk) {
      if (t < 256) { int pn, pm; tile_map(t, 32, 8, pm, pn); EpiRes e{&p, nullptr, (float*)(ws + W_X1), (const float*)(ws + W_MOD) + 4096, pm, pn};
        gemm_tile(lds, (const bf16_t*)(ws + W_O) + (size_t)pm * 256 * 2048, 2048, (const bf16_t*)(ws + W_WOUTT) + (size_t)pn * 256 * 2048, 2048, 2048, e); }
      else { const int u = t - 256, kc = u % NCH5, tl = u / NCH5, pms = tl & 1, pn = tl >> 1; constexpr int KC = 2048 / NCH5;
        EpiPart e{(float*)(ws + W_OA) + ((size_t)kc * 512 + pms * 256) * 4096 + pn * 256};
        flag_wait(oflag, 16u);
        gemm_tile(lds, (const bf16_t*)(ws + W_O) + (size_t)(TP + pms * 256) * 2048 + kc * KC, 2048, (const bf16_t*)(ws + W_WOUTT) + (size_t)pn * 256 * 2048 + kc * KC, 2048, KC, e); }
    }
  }
  xcd_barrier(xbar, xst);
  for (int rep_e = 0; rep_e < REP_P6; ++rep_e) phase_norm<1>(p, lds);
  xcd_barrier(xbar, xst);
  auto ptrs_p7 = [&](int t, const bf16_t*& a, const bf16_t*& b2) { constexpr int KC = 2048 / NCH7;
    if (t < 512) { int pn, pm; tile_map(t, 32, 16, pm, pn); a = (const bf16_t*)(ws + W_H) + (size_t)pm * 256 * 2048; b2 = (const bf16_t*)(ws + W_WINPT) + (size_t)pn * 256 * 2048; }
    else { const int u = t - 512, kc = u % NCH7, tl = u / NCH7, pms = tl & 1, pn = tl >> 1; a = (const bf16_t*)(ws + W_H) + (size_t)(TP + pms * 256) * 2048 + kc * KC; b2 = (const bf16_t*)(ws + W_WINPT) + (size_t)pn * 256 * 2048 + kc * KC; } };
  for (int rep = 0; rep < REP_G; ++rep) for (int t = bid; t < 512 + 32 * NCH7; t += nblk) {
    const bf16_t* nA = nullptr; const bf16_t* nB = nullptr; if (t + nblk < 512 + 32 * NCH7) ptrs_p7(t + nblk, nA, nB);
    if (t < 512) { int pn, pm; tile_map(t, 32, 16, pm, pn); EpiInPool e{&p, pm, pn};
      gemm_tile(lds, (const bf16_t*)(ws + W_H) + (size_t)pm * 256 * 2048, 2048, (const bf16_t*)(ws + W_WINPT) + (size_t)pn * 256 * 2048, 2048, 2048, e, t != bid, nA, nB); }
    else { const int u = t - 512, kc = u % NCH7, tl = u / NCH7, pms = tl & 1, pn = tl >> 1; constexpr int KC = 2048 / NCH7;
      EpiPart e{(float*)(ws + W_OA) + ((size_t)kc * 512 + pms * 256) * 4096 + pn * 256};
      gemm_tile(lds, (const bf16_t*)(ws + W_H) + (size_t)(TP + pms * 256) * 2048 + kc * KC, 2048, (const bf16_t*)(ws + W_WINPT) + (size_t)pn * 256 * 2048 + kc * KC, 2048, KC, e, t != bid, nA, nB); }
  }
  xcd_barrier(xbar, xst);
  for (int rep_e = 0; rep_e < REP_P8A; ++rep_e) {
    PH_VARS
    const float* U = (const float*)(ws + W_U); bf16_t* D = (bf16_t*)(ws + W_D); const float* SP = p.in[8];
    const int c = tid * 4, g = tid >> 7;
    for (int it = bid; it < TT / 4; it += nblk) { const int tok0 = it * 4; const bool prm = tok0 < TP; const int s0 = prm ? (tok0 & 4095) : ((tok0 - TP) & 31); const int bs = prm ? 0 : (tok0 - TP) >> 5;
      const float* PART = (const float*)(ws + W_OA);
      auto fetch = [&](int s) -> f32x4 {
        if (prm) { if (s >= 0) return *(const f32x4*)(U + (size_t)(tok0 - s0 + s) * DM + c); return (f32x4){0.f, 0.f, 0.f, 0.f}; }
        if (s >= 0) return part_sum<NCH7>(PART, bs * 32 + s, c);
        return *(const f32x4*)(SP + ((size_t)bs * 15 + 15 + s) * DM + c); };
      if (!prm) {
        bf16_t* SGw = (bf16_t*)(ws + W_SG);
#pragma unroll
        for (int rr = 0; rr < 4; ++rr) { const int s = s0 + rr; const f32x4 gsum = part_sum<NCH7>(PART, bs * 32 + s, 2048 + c);
          f32x4 sg; sg[0] = silu(gsum[0]); sg[1] = silu(gsum[1]); sg[2] = silu(gsum[2]); sg[3] = silu(gsum[3]); *(u32x2*)(SGw + (size_t)(tok0 + rr) * DM + c) = pack4(sg);
          if (s >= 17) *(f32x4*)(out + O_POOLS + ((size_t)bs * 15 + (s - 17)) * DM + c) = part_sum<NCH7>(PART, bs * 32 + s, c); } }
      auto run = [&](auto wtag) { constexpr int W = decltype(wtag)::value; f32x4 r[W + 3];
#pragma unroll
        for (int j = 0; j < W + 3; ++j) r[j] = fetch(s0 - (W - 1) + j);
        f32x4 sum = r[0];
#pragma unroll
        for (int j = 1; j < W; ++j) sum += r[j];
#pragma unroll
        for (int rr = 0; rr < 4; ++rr) { const int s = s0 + rr; const float cntf = prm ? (float)(s + 1 < W ? s + 1 : W) : (float)W;
          *(u32x2*)(D + (size_t)(tok0 + rr) * DM + c) = pack4(sum * (1.f / cntf) - r[W - 1 + rr]);
          if (rr < 3) sum += r[W + rr] - r[rr]; } };
      if (g == 0) run(std::integral_constant<int, 2>{}); else if (g == 1) run(std::integral_constant<int, 4>{}); else if (g == 2) run(std::integral_constant<int, 8>{}); else run(std::integral_constant<int, 16>{});
    }
  }
  xcd_barrier(xbar, xst);
  for (int rep = 0; rep < REP_G; ++rep) for (int t = bid; t < 34 * 8; t += nblk) { int pm, gn; tile_map(t, 34, 8, pm, gn); const int g = gn >> 1, pn = gn & 1; EpiGrp e{(bf16_t*)(ws + W_MX), (const bf16_t*)(ws + W_SG), p.in[27], pm * 256, g * 512 + pn * 256};
    gemm_tile(lds, (const bf16_t*)(ws + W_D) + (size_t)pm * 256 * 2048 + g * 512, 2048, (const bf16_t*)(ws + W_WGRPT) + ((size_t)g * 512 + pn * 256) * 512, 512, 512, e); }
  xcd_barrier(xbar, xst);
  auto ptrs_p9 = [&](int t, const bf16_t*& a, const bf16_t*& b2) { constexpr int KC = 2048 / NCH5;
    if (t < 256) { int pn, pm; tile_map(t, 32, 8, pm, pn); a = (const bf16_t*)(ws + W_MX) + (size_t)pm * 256 * 2048; b2 = (const bf16_t*)(ws + W_WOUTPT) + (size_t)pn * 256 * 2048; }
    else { const int u = t - 256, kc = u % NCH5, tl = u / NCH5, pms = tl & 1, pn = tl >> 1; a = (const bf16_t*)(ws + W_MX) + (size_t)(TP + pms * 256) * 2048 + kc * KC; b2 = (const bf16_t*)(ws + W_WOUTPT) + (size_t)pn * 256 * 2048 + kc * KC; } };
  for (int rep = 0; rep < REP_G; ++rep) for (int t = bid; t < 256 + 16 * NCH5; t += nblk) {
    const bf16_t* nA = nullptr; const bf16_t* nB = nullptr; if (t + nblk < 256 + 16 * NCH5) ptrs_p9(t + nblk, nA, nB);
    if (t < 256) { int pn, pm; tile_map(t, 32, 8, pm, pn); EpiRes e{&p, (const float*)(ws + W_X1), out + O_Y, (const float*)(ws + W_MOD) + (size_t)NB * 6144 + 4096, pm, pn};
      gemm_tile(lds, (const bf16_t*)(ws + W_MX) + (size_t)pm * 256 * 2048, 2048, (const bf16_t*)(ws + W_WOUTPT) + (size_t)pn * 256 * 2048, 2048, 2048, e, t != bid, nA, nB); }
    else { const int u = t - 256, kc = u % NCH5, tl = u / NCH5, pms = tl & 1, pn = tl >> 1; constexpr int KC = 2048 / NCH5;
      EpiPart e{(float*)(ws + W_OA) + ((size_t)kc * 512 + pms * 256) * 4096 + pn * 256};
      gemm_tile(lds, (const bf16_t*)(ws + W_MX) + (size_t)(TP + pms * 256) * 2048 + kc * KC, 2048, (const bf16_t*)(ws + W_WOUTPT) + (size_t)pn * 256 * 2048 + kc * KC, 2048, KC, e, t != bid, nA, nB); }
  }
  xcd_barrier(xbar, xst);
  {
    PH_VARS
    const float* gf = p.in[29];
    for (int tok = bid * 8 + wid; tok < TT; tok += nblk * 8) { float* yr = out + O_Y + (size_t)tok * DM;
      f32x4 v[8]; float ss = 0.f;
      if (tok >= TP) {
        const float* x1r = (const float*)(ws + W_X1) + (size_t)tok * DM; const float* g1 = (const float*)(ws + W_MOD) + ((size_t)NB + tok_batch(tok)) * 6144 + 4096; const float* PART = (const float*)(ws + W_OA);
#pragma unroll
        for (int i = 0; i < 8; ++i) { const int k = (i * 64 + lane) * 4; v[i] = *(const f32x4*)(x1r + k) + *(const f32x4*)(g1 + k) * part_sum<NCH5>(PART, tok - TP, k); } }
      else {
#pragma unroll
        for (int i = 0; i < 8; ++i) v[i] = *(const f32x4*)(yr + (i * 64 + lane) * 4); }
#pragma unroll
      for (int i = 0; i < 8; ++i) ss += v[i][0] * v[i][0] + v[i][1] * v[i][1] + v[i][2] * v[i][2] + v[i][3] * v[i][3];
      ss = wave_sum(ss); const float rstd = rsqrtf(ss * (1.f / 2048.f) + 1e-6f);
#pragma unroll
      for (int i = 0; i < 8; ++i) { const int k = (i * 64 + lane) * 4; *(f32x4*)(yr + k) = v[i] * rstd * *(const f32x4*)(gf + k); } }
  }
}

extern "C" void kernel_launch(void* const* d_in, const int* in_sizes, int n_in, void* d_out, int out_size, void* d_ws, size_t ws_size, hipStream_t stream) {
  static int grid_blocks = 0;
  if (!grid_blocks) {
    int dev = 0, cus = 0, per_cu = 0;
    (void)hipGetDevice(&dev);
    (void)hipDeviceGetAttribute(&cus, hipDeviceAttributeMultiprocessorCount, dev);
    (void)hipFuncSetAttribute((const void*)mega, hipFuncAttributeMaxDynamicSharedMemorySize, DYN_LDS);
    (void)hipOccupancyMaxActiveBlocksPerMultiprocessor(&per_cu, mega, 512, DYN_LDS);
    if (per_cu < 1) { fprintf(stderr, "occupancy query returned %d\n", per_cu); per_cu = 1; }
    grid_blocks = cus;
    if (ws_size < W_END) fprintf(stderr, "workspace too small: %zu < %zu\n", ws_size, (size_t)W_END);
  }
  Params p{};
  for (int i = 0; i < 30; ++i) p.in[i] = (const float*)d_in[i];
  p.out = (float*)d_out; p.ws = (char*)d_ws;
  void* args[] = {&p};
  hipError_t e = hipLaunchCooperativeKernel((void*)mega, dim3(grid_blocks), dim3(512), args, DYN_LDS, stream);
  if (e != hipSuccess) fprintf(stderr, "cooperative launch failed: %s (grid %d)\n", hipGetErrorString(e), grid_blocks);
}
```

```cpp
#include <hip/hip_runtime.h>
#include <hip/hip_cooperative_groups.h>
#include <cstdio>
#include <type_traits>
namespace cg = cooperative_groups;

typedef unsigned short bf16_t;
typedef short bf16x8 __attribute__((ext_vector_type(8)));
typedef short s16x4 __attribute__((ext_vector_type(4)));
typedef float f32x4 __attribute__((ext_vector_type(4)));
typedef float f32x2 __attribute__((ext_vector_type(2)));
typedef unsigned u32x4 __attribute__((ext_vector_type(4)));
typedef unsigned u32x2 __attribute__((ext_vector_type(2)));
#define LAS __attribute__((address_space(3)))
#define DI __device__ __forceinline__

constexpr int XCD_BAR_WORDS_C = 3456;
constexpr int DM = 2048, TP = 8192, TS = 512, TT = 8704, SEQ = 4096, PAST = 4096, NSB = 16, NB = 18;
constexpr int IN_ATT = 6208, IN_ATT_PAD = 6400;
constexpr float LOG2E = 1.4426950408889634f;
constexpr float C_DIFF = 0.125f * LOG2E;
constexpr float C_MLA = 0.07216878364870323f * LOG2E;
constexpr size_t O_Y = 0, O_KP = 17825792, O_VP = 26214400, O_CKVP = 34603008, O_KPEP = 38797312, O_POOLP = 39321600,
                 O_KS = 39383040, O_VS = 39907328, O_CKVS = 40431616, O_KPES = 40693760, O_POOLS = 40726528;
constexpr size_t al256(size_t x) { return (x + 255) / 256 * 256; }
constexpr size_t W_WINT = 0;
constexpr size_t W_WOUTT = W_WINT + al256((size_t)IN_ATT_PAD * 2048 * 2);
constexpr size_t W_WQT = W_WOUTT + al256((size_t)2048 * 2048 * 2);
constexpr size_t W_WKVT = W_WQT + al256((size_t)1536 * 512 * 2);
constexpr size_t W_WUKP = W_WKVT + al256((size_t)2304 * 512 * 2);
constexpr size_t W_WINPT = W_WUKP + al256((size_t)8 * 512 * 256 * 2);
constexpr size_t W_WGRPT = W_WINPT + al256((size_t)4096 * 2048 * 2);
constexpr size_t W_WOUTPT = W_WGRPT + al256((size_t)4 * 512 * 512 * 2);
constexpr size_t W_MODP = W_WOUTPT + al256((size_t)2048 * 2048 * 2);
constexpr size_t W_MOD = W_MODP + al256((size_t)8 * 2 * NB * 6144 * 4);
constexpr size_t W_ROPE = W_MOD + al256((size_t)2 * NB * 6144 * 4);
constexpr size_t W_CNT = W_ROPE + al256((size_t)4128 * 32 * 8);
constexpr size_t W_BAR = W_CNT + 256;
constexpr size_t W_H = W_BAR + al256((size_t)XCD_BAR_WORDS_C * 4);
constexpr size_t W_QA = W_H + al256((size_t)TT * 2048 * 2);
constexpr size_t W_KA = W_QA + al256((size_t)TT * 1024 * 2);
constexpr size_t W_VA = W_KA + al256((size_t)TT * 1024 * 2);
constexpr size_t W_CQ = W_VA + al256((size_t)TT * 1024 * 2);
constexpr size_t W_CKVR = W_CQ + al256((size_t)TT * 512 * 4);
constexpr size_t W_SG = W_CKVR + al256((size_t)TT * 512 * 4);
constexpr size_t W_CQN = W_SG + al256((size_t)TT * 2048 * 2);
constexpr size_t W_CKVN = W_CQN + al256((size_t)TT * 512 * 2);
constexpr size_t W_KPE = W_CKVN + al256((size_t)TT * 512 * 2);
constexpr size_t W_QM = W_KPE + al256((size_t)TT * 64 * 2);
constexpr size_t W_KM = W_QM + al256((size_t)TP * 1536 * 2);
constexpr size_t W_VM = W_KM + al256((size_t)TP * 1024 * 2);
constexpr size_t W_QNS = W_VM + al256((size_t)TP * 1024 * 2);
constexpr size_t W_QS = W_QNS + al256((size_t)TS * 1024 * 2);
constexpr size_t W_CC = W_QS + al256((size_t)NSB * 256 * 576 * 2);
constexpr size_t W_OA = W_CC + al256((size_t)NSB * 4160 * 576 * 2);
constexpr size_t W_OPD = W_OA + al256((size_t)TP * 8 * 2 * 128 * 4);
constexpr size_t W_MLD = W_OPD + al256((size_t)NSB * 8 * 2 * 2 * 32 * 128 * 4);
constexpr size_t W_OPM = W_MLD + al256((size_t)NSB * 8 * 2 * 2 * 32 * 2 * 4);
constexpr size_t W_MLM = W_OPM + al256((size_t)NSB * 256 * 4 * 512 * 4);
constexpr size_t W_OLAT = W_MLM + al256((size_t)NSB * 256 * 4 * 2 * 4);
constexpr size_t W_O = W_OLAT + al256((size_t)TS * 8 * 512 * 2);
constexpr size_t W_X1 = W_O + al256((size_t)TT * 2048 * 2);
constexpr size_t W_U = W_X1 + al256((size_t)TT * 2048 * 4);
constexpr size_t W_D = W_U + al256((size_t)TT * 2048 * 4);
constexpr size_t W_MX = W_D + al256((size_t)TT * 2048 * 2);
constexpr size_t W_END = W_MX + al256((size_t)TT * 2048 * 2);

constexpr int DYN_LDS = 149504;
#ifndef REP_P0
#define REP_P0 1
#endif
#ifndef REP_P4
#define REP_P4 1
#endif
#ifndef REP_G
#define REP_G 1
#endif
#ifndef REP_E
#define REP_E 1
#endif
#define REP_P1 1
#define REP_P2B 1
#define REP_P4B 1
#define REP_P6 1
#define REP_P8A 1
#define REP_PM 1
#define REP_SM 1
#define REP_PD 1
#define REP_SD 1

struct Params { const float* in[30]; float* out; char* ws; };

typedef __bf16 bf16x2_t __attribute__((ext_vector_type(2)));
DI unsigned cvtpk(float lo, float hi) { const f32x2 v = {lo, hi}; return __builtin_bit_cast(unsigned, __builtin_convertvector(v, bf16x2_t)); }
DI int my_tid() { int t = threadIdx.x; asm volatile("" : "+v"(t)); return t; }
DI float bf2f(unsigned short b) { return __uint_as_float(((unsigned)b) << 16); }
DI float bflo(unsigned w) { return __uint_as_float(w << 16); }
DI float bfhi(unsigned w) { return __uint_as_float(w & 0xffff0000u); }
DI float silu(float x) { return x * __builtin_amdgcn_rcpf(1.f + __expf(-x)); }
DI u32x2 pack4(f32x4 v) { u32x2 w; w.x = cvtpk(v[0], v[1]); w.y = cvtpk(v[2], v[3]); return w; }
DI f32x4 unpack4(u32x2 w) { return (f32x4){bflo(w.x), bfhi(w.x), bflo(w.y), bfhi(w.y)}; }
DI float quad_max(float v) { auto a = __builtin_amdgcn_permlane16_swap(__float_as_uint(v), __float_as_uint(v), false, false); v = fmaxf(__uint_as_float(a[0]), __uint_as_float(a[1]));
  auto b = __builtin_amdgcn_permlane32_swap(__float_as_uint(v), __float_as_uint(v), false, false); return fmaxf(__uint_as_float(b[0]), __uint_as_float(b[1])); }
DI float quad_sum(float v) { auto a = __builtin_amdgcn_permlane16_swap(__float_as_uint(v), __float_as_uint(v), false, false); v = __uint_as_float(a[0]) + __uint_as_float(a[1]);
  auto b = __builtin_amdgcn_permlane32_swap(__float_as_uint(v), __float_as_uint(v), false, false); return __uint_as_float(b[0]) + __uint_as_float(b[1]); }
DI float wave_sum(float v) { for (int o = 32; o >= 1; o >>= 1) v += __shfl_xor(v, o); return v; }
DI int tok_batch(int tok) { return tok < TP ? (tok >> 12) : 2 + ((tok - TP) >> 5); }
DI int tok_pos(int tok) { return tok < TP ? (tok & 4095) : PAST + ((tok - TP) & 31); }
DI const float* x_row(const Params& p, int tok) { return tok < TP ? p.in[0] + (size_t)tok * DM : p.in[1] + (size_t)(tok - TP) * DM; }


#define XB_TMO      128
#define XB_XCNT(j)  (256  + 64 * (j))
#define XB_XSUB(j)  (1280 + 64 * (j))
#define XB_XGEN(j)  (2304 + 64 * (j))
#define XB_TOP      3328
#define XB_TOPGEN   3392
#define XCD_BAR_WORDS 3456
#define XB_SPIN_CAP (1u << 22)
DI unsigned xb_ld(unsigned* p)              { return __hip_atomic_load(p, __ATOMIC_RELAXED, __HIP_MEMORY_SCOPE_AGENT); }
DI unsigned xb_add(unsigned* p, unsigned v) { return __hip_atomic_fetch_add(p, v, __ATOMIC_RELAXED, __HIP_MEMORY_SCOPE_AGENT); }
DI unsigned xb_xcc_id() { return (unsigned)__builtin_amdgcn_s_getreg((3 << 11) | 20) & 0xFu; }
#define XB_SPIN(cond, bar) do { unsigned _sp = 0; while (cond) { __builtin_amdgcn_s_sleep(1); \
    if ((++_sp & 255u) == 0u) { if (xb_ld(&(bar)[XB_TMO])) break; if (_sp > XB_SPIN_CAP) { atomicAdd(&(bar)[XB_TMO], 1u); break; } } } } while (0)
DI void xcd_barrier_post(unsigned* bar) { if (threadIdx.x == 0) (void)xb_add(&bar[XB_XCNT(xb_xcc_id())], 1u); }
DI void xcd_barrier_complete(unsigned* bar, unsigned x, unsigned& nloc, unsigned& nx) {
  const unsigned G = gridDim.x; unsigned sum, cnt, mine, sp = 0u;
  for (;;) { sum = 0u; cnt = 0u; mine = 0u;
#pragma unroll
    for (unsigned j = 0; j < 16; ++j) { const unsigned c = xb_ld(&bar[XB_XCNT(j)]); sum += c; cnt += (c > 0u) ? 1u : 0u; mine = (j == x) ? c : mine; }
    if (sum == G) break;
    __builtin_amdgcn_s_sleep(1);
    if ((++sp & 255u) == 0u) { if (xb_ld(&bar[XB_TMO])) break; if (sp > XB_SPIN_CAP) { atomicAdd(&bar[XB_TMO], 1u); break; } } }
  nloc = mine > 0u ? mine : 1u; nx = cnt > 0u ? cnt : 1u;
}
DI void xcd_barrier(unsigned* bar, volatile LAS unsigned* st) {
  asm volatile("s_waitcnt vmcnt(0)" ::: "memory");
  __syncthreads();
  if (threadIdx.x == 0) {
    const unsigned x = xb_xcc_id();
    __builtin_amdgcn_s_waitcnt(0);
    unsigned nloc = st[0], nx = st[1];
    if (nloc == 0u) { xcd_barrier_complete(bar, x, nloc, nx); st[0] = nloc; st[1] = nx; }
    const unsigned old = xb_add(&bar[XB_XSUB(x)], 1u);
    const unsigned gen = old / nloc;
    if (old + 1u == (gen + 1u) * nloc) {
      __builtin_amdgcn_fence(__ATOMIC_RELEASE, "agent");
      asm volatile("s_waitcnt vmcnt(0)" ::: "memory");
      const unsigned og = xb_add(&bar[XB_TOP], 1u);
      const unsigned tg = og / nx;
      if (og + 1u == (tg + 1u) * nx) xb_add(&bar[XB_TOPGEN], 1u);
      else XB_SPIN(xb_ld(&bar[XB_TOPGEN]) == tg, bar);
      __builtin_amdgcn_fence(__ATOMIC_ACQUIRE, "agent");
      xb_add(&bar[XB_XGEN(x)], 1u);
      asm volatile("s_waitcnt vmcnt(0)" ::: "memory");
    } else {
      XB_SPIN(xb_ld(&bar[XB_XGEN(x)]) == gen, bar);
      __builtin_amdgcn_fence(__ATOMIC_ACQUIRE, "agent");
      asm volatile("s_waitcnt vmcnt(0)" ::: "memory");
    }
  }
  __syncthreads();
}

DI void flag_publish(unsigned* flag) { __threadfence(); __syncthreads(); if (threadIdx.x == 0) (void)xb_add(flag, 1u); }
DI void flag_wait(unsigned* flag, unsigned need) {
  if (threadIdx.x == 0) { unsigned sp = 0; while (xb_ld(flag) < need) { __builtin_amdgcn_s_sleep(4); if (++sp > (1u << 24)) break; } }
  __syncthreads();
  __builtin_amdgcn_fence(__ATOMIC_ACQUIRE, "agent");
  asm volatile("s_waitcnt vmcnt(0)" ::: "memory");
}
constexpr int BK = 64, HALF = 128, HTB = HALF * BK * 2;
DI int lds_byte(int r, int c) { const int st = (r >> 4) * 2 + (c >> 5), rr = r & 15, cc = c & 31, ob = rr * 64 + cc * 2; return st * 1024 + (ob ^ (((ob >> 9) & 1) << 5)); }
DI void stage_rc(int b, int& R, int& C) { const int st = b / 1024, sb = b % 1024, swz = sb ^ (((sb >> 9) & 1) << 5); R = (st >> 1) * 16 + swz / 64; C = (st & 1) * 32 + (swz % 64) / 2; }

template <class Epi>
DI void gemm_tile(LAS char* lds, const bf16_t* __restrict__ A, int lda, const bf16_t* __restrict__ Bt, int ldb, int K, const Epi& epi,
                  bool pre = false, const bf16_t* nA = nullptr, const bf16_t* nB = nullptr) {
  const int tid = my_tid(), wid = __builtin_amdgcn_readfirstlane(tid >> 6), lane = tid & 63, wr = wid >> 2, wc = wid & 3, fr = lane & 15, fq = lane >> 4;
  int offA[2], offB[2];
#pragma unroll
  for (int i = 0; i < 2; ++i) { int R, C; stage_rc(tid * 16 + i * 8192, R, C); offA[i] = R * lda + C; offB[i] = R * ldb + C; }
  const unsigned ldsw = (unsigned)wid * 1024u;
  const int aoff = lds_byte(wr * 64 + fr, fq * 8), boff = lds_byte(wc * 32 + fr, fq * 8);
  const size_t hA = (size_t)HALF * lda, hB = (size_t)HALF * ldb;
#define G_SA(b, h) (((b) * 2 + (h)) * HTB)
#define G_SB(b, h) ((4 + (b) * 2 + (h)) * HTB)
#define G_STAGE(bufoff, gptr, off) do { _Pragma("unroll") for (int _i = 0; _i < 2; ++_i) \
    __builtin_amdgcn_global_load_lds((const unsigned*)((gptr) + (off)[_i]), (LAS unsigned*)(lds + (bufoff) + ldsw + _i * 8192), 16, 0, 0); } while (0)
#define G_LDA(dst, b, h) do { _Pragma("unroll") for (int m = 0; m < 4; ++m) _Pragma("unroll") for (int k = 0; k < 2; ++k) dst[m][k] = *(const LAS bf16x8*)(lds + G_SA(b, h) + aoff + m * 2048 + k * 1024); } while (0)
#define G_LDB(dst, b, h) do { _Pragma("unroll") for (int n = 0; n < 2; ++n) _Pragma("unroll") for (int k = 0; k < 2; ++k) dst[n][k] = *(const LAS bf16x8*)(lds + G_SB(b, h) + boff + n * 2048 + k * 1024); } while (0)
#define G_MMA(ai, bj, At, Bq) do { __builtin_amdgcn_s_setprio(1); _Pragma("unroll") for (int m = 0; m < 4; ++m) _Pragma("unroll") for (int n = 0; n < 2; ++n) _Pragma("unroll") for (int k = 0; k < 2; ++k) \
    acc[ai][bj][m][n] = __builtin_amdgcn_mfma_f32_16x16x32_bf16(Bq[n][k], At[m][k], acc[ai][bj][m][n], 0, 0, 0); __builtin_amdgcn_s_setprio(0); } while (0)
#define G_WV(n) asm volatile("s_waitcnt vmcnt(" #n ")" ::: "memory")
#define G_WL(n) asm volatile("s_waitcnt lgkmcnt(" #n ")" ::: "memory")
#define G_BAR __builtin_amdgcn_s_barrier()
#define G_SCHED __builtin_amdgcn_sched_barrier(0)
  f32x4 acc[2][2][4][2];
#pragma unroll
  for (int a = 0; a < 2; ++a)
#pragma unroll
    for (int b = 0; b < 2; ++b)
#pragma unroll
      for (int m = 0; m < 4; ++m)
#pragma unroll
        for (int n = 0; n < 2; ++n) acc[a][b][m][n] = (f32x4){0.f, 0.f, 0.f, 0.f};
  bf16x8 At[4][2], B0[2][2], B1[2][2];
  const int nt = K / BK;
  const bf16_t* pA = A; const bf16_t* pB = Bt;
  if (!pre) { G_STAGE(G_SB(0, 0), pB, offB); G_STAGE(G_SA(0, 0), pA, offA); G_STAGE(G_SB(0, 1), pB + hB, offB); G_STAGE(G_SA(0, 1), pA + hA, offA); }
  if (wr == 1) G_BAR;
  G_WV(4); G_BAR;
  G_STAGE(G_SB(1, 0), pB + BK, offB); G_STAGE(G_SA(1, 0), pA + BK, offA); G_STAGE(G_SB(1, 1), pB + hB + BK, offB);
  G_WV(6); G_BAR;
  for (int t = 0; t < nt - 2; t += 2) {
    const bf16_t* a1 = pA + (t + 1) * BK; const bf16_t* a2 = pA + (t + 2) * BK; const bf16_t* a3 = pA + (t + 3) * BK;
    const bf16_t* b2 = pB + (t + 2) * BK; const bf16_t* b3 = pB + (t + 3) * BK;
    G_LDB(B0, 0, 0); G_SCHED; G_LDA(At, 0, 0); G_STAGE(G_SA(1, 1), a1 + hA, offA);
    G_WL(8); G_BAR; G_WL(0); G_MMA(0, 0, At, B0); G_BAR; G_SCHED;
    G_LDB(B1, 0, 1); G_STAGE(G_SB(0, 0), b2, offB);
    G_BAR; G_WL(0); G_MMA(0, 1, At, B1); G_BAR;
    G_LDA(At, 0, 1); G_STAGE(G_SA(0, 0), a2, offA);
    G_BAR; G_WL(0); G_MMA(1, 0, At, B0); G_BAR; G_SCHED;
    G_STAGE(G_SB(0, 1), b2 + hB, offB);
    G_WV(6); G_BAR; G_MMA(1, 1, At, B1); G_BAR;
    G_LDB(B0, 1, 0); G_SCHED; G_LDA(At, 1, 0); G_STAGE(G_SA(0, 1), a2 + hA, offA);
    G_WL(8); G_BAR; G_WL(0); G_MMA(0, 0, At, B0); G_BAR; G_SCHED;
    G_LDB(B1, 1, 1); G_STAGE(G_SB(1, 0), b3, offB);
    G_BAR; G_WL(0); G_MMA(0, 1, At, B1); G_BAR;
    G_LDA(At, 1, 1); G_STAGE(G_SA(1, 0), a3, offA);
    G_BAR; G_WL(0); G_MMA(1, 0, At, B0); G_BAR; G_SCHED;
    G_STAGE(G_SB(1, 1), b3 + hB, offB);
    G_WV(6); G_BAR; G_MMA(1, 1, At, B1); G_BAR;
  }
  { G_LDB(B0, 0, 0); G_LDA(At, 0, 0); G_STAGE(G_SA(1, 1), pA + (nt - 1) * BK + hA, offA);
    G_BAR; G_WL(0); G_MMA(0, 0, At, B0); G_BAR;
    G_LDB(B1, 0, 1); G_BAR; G_WL(0); G_MMA(0, 1, At, B1); G_BAR;
    G_LDA(At, 0, 1); G_WV(4); G_BAR; G_WL(0); G_MMA(1, 0, At, B0); G_MMA(1, 1, At, B1); G_BAR; }
  { G_LDB(B0, 1, 0); G_LDA(At, 1, 0); G_WV(2); G_BAR; G_WL(0); G_MMA(0, 0, At, B0); G_BAR;
    G_LDB(B1, 1, 1); G_WV(0); G_BAR; G_WL(0); G_MMA(0, 1, At, B1); G_BAR;
    G_LDA(At, 1, 1); G_BAR; G_WL(0); G_MMA(1, 0, At, B0); G_MMA(1, 1, At, B1); G_BAR; }
  if (wr == 0) G_BAR;
  if (nA) { G_STAGE(G_SB(0, 0), nB, offB); G_STAGE(G_SA(0, 0), nA, offA); G_STAGE(G_SB(0, 1), nB + hB, offB); G_STAGE(G_SA(0, 1), nA + hA, offA); }
  epi(acc, wr, wc, fr, fq);
#undef G_SA
#undef G_SB
#undef G_STAGE
#undef G_LDA
#undef G_LDB
#undef G_MMA
}

DI void tile_map(int L, int nM, int nN, int& pm, int& pn) {
  const int nwg = nM * nN, q = nwg / 8, r = nwg % 8, xcd = L % 8, off = L / 8;
  const int w = (xcd < r ? xcd * (q + 1) : r * (q + 1) + (xcd - r) * q) + off;
  const int nig = 8 * nN, gid = w / nig, fm = gid * 8, gsz = (nM - fm) < 8 ? (nM - fm) : 8;
  pm = fm + ((w % nig) % gsz); pn = (w % nig) / gsz;
}
#define EPI_LOOP(...) \
  _Pragma("unroll") for (int ai = 0; ai < 2; ++ai) _Pragma("unroll") for (int m = 0; m < 4; ++m) { const int rl = ai * 128 + wr * 64 + m * 16 + fr; \
    _Pragma("unroll") for (int bj = 0; bj < 2; ++bj) _Pragma("unroll") for (int n = 0; n < 2; ++n) { const int cl = bj * 128 + wc * 32 + n * 16 + fq * 4; const f32x4 v = acc[ai][bj][m][n]; __VA_ARGS__ } }

typedef f32x4 AccT[2][2][4][2];

struct EpiInAtt {
  const Params* p; int pm, pn;
  DI void operator()(const AccT& acc, int wr, int wc, int fr, int fq) const {
    char* ws = p->ws; float* out = p->out;
    const int r0 = pm * 256, c0 = pn * 256;
    if (pn < 4) { bf16_t* QA = (bf16_t*)(ws + W_QA);
      EPI_LOOP({ *(u32x2*)(QA + (size_t)(r0 + rl) * 1024 + c0 + cl) = pack4(v * C_DIFF); })
    } else if (pn < 12) {
      const bool isk = pn < 8; bf16_t* KB = (bf16_t*)(ws + (isk ? W_KA : W_VA)); const int cb = c0 - (isk ? 1024 : 2048);
      EPI_LOOP({ const int tok = r0 + rl; float* o = tok < TP ? out + (isk ? O_KP : O_VP) + (size_t)tok * 1024 : out + (isk ? O_KS : O_VS) + (size_t)(tok - TP) * 1024;
                 *(f32x4*)(o + cb + cl) = v; *(u32x2*)(KB + (size_t)tok * 1024 + cb + cl) = pack4(v); })
    } else if (pn < 16) {
      float* F = (float*)(ws + (pn < 14 ? W_CQ : W_CKVR)); const int cb = c0 - (pn < 14 ? 3072 : 3584);
      EPI_LOOP({ *(f32x4*)(F + (size_t)(r0 + rl) * 512 + cb + cl) = v; })
    } else {
      bf16_t* SG = (bf16_t*)(ws + W_SG); bf16_t* KPE = (bf16_t*)(ws + W_KPE); bf16_t* CC = (bf16_t*)(ws + W_CC); const float* ROPE = (const float*)(ws + W_ROPE);
      EPI_LOOP({ const int tok = r0 + rl; const int col = c0 + cl;
        if (col >= 4160) { if (col < IN_ATT) { f32x4 s; s[0] = silu(v[0]); s[1] = silu(v[1]); s[2] = silu(v[2]); s[3] = silu(v[3]); *(u32x2*)(SG + (size_t)tok * 2048 + (col - 4160)) = pack4(s); } }
        else { const int r = (col - 4096) >> 1; const int pos = tok_pos(tok); const f32x4 cs = *(const f32x4*)(ROPE + ((size_t)pos * 32 + r) * 2);
          const float a0 = v[0] * cs[0] - v[1] * cs[1], b0 = v[0] * cs[1] + v[1] * cs[0], a1 = v[2] * cs[2] - v[3] * cs[3], b1 = v[2] * cs[3] + v[3] * cs[2];
          float* o = tok < TP ? out + O_KPEP + (size_t)tok * 64 : out + O_KPES + (size_t)(tok - TP) * 64;
          *(f32x2*)(o + r) = (f32x2){a0, a1}; *(f32x2*)(o + 32 + r) = (f32x2){b0, b1};
          const unsigned wa = cvtpk(a0, a1), wb = cvtpk(b0, b1);
          *(unsigned*)(KPE + (size_t)tok * 64 + r) = wa; *(unsigned*)(KPE + (size_t)tok * 64 + 32 + r) = wb;
          if (tok >= TP) { const int bs = (tok - TP) >> 5, s = (tok - TP) & 31; bf16_t* cc = CC + ((size_t)bs * 4160 + 4096 + s) * 576 + 512; *(unsigned*)(cc + r) = wa; *(unsigned*)(cc + 32 + r) = wb; } } })
    }
  }
};
struct EpiQ {
  const Params* p; int pm, pn;
  DI void operator()(const AccT& acc, int wr, int wc, int fr, int fq) const {
    char* ws = p->ws; const int r0 = pm * 256, c0 = pn * 256;
    bf16_t* QM = (bf16_t*)(ws + W_QM); bf16_t* QNS = (bf16_t*)(ws + W_QNS); bf16_t* QS = (bf16_t*)(ws + W_QS); const float* ROPE = (const float*)(ws + W_ROPE);
    if (pn < 4) {
      EPI_LOOP({ const int tok = r0 + rl; const int col = c0 + cl; const int h = col >> 7, d = col & 127;
        const f32x4 vs = v * C_MLA;
        if (tok < TP) *(u32x2*)(QM + (size_t)tok * 1536 + h * 192 + d) = pack4(vs); else *(u32x2*)(QNS + (size_t)(tok - TP) * 1024 + col) = pack4(vs); })
    } else {
      EPI_LOOP({ const int tok = r0 + rl; const int col = c0 + cl - 1024; const int h = col >> 6, r = (col & 63) >> 1; const int pos = tok_pos(tok);
        const f32x4 cs = *(const f32x4*)(ROPE + ((size_t)pos * 32 + r) * 2);
        const float a0 = (v[0] * cs[0] - v[1] * cs[1]) * C_MLA, b0 = (v[0] * cs[1] + v[1] * cs[0]) * C_MLA, a1 = (v[2] * cs[2] - v[3] * cs[3]) * C_MLA, b1 = (v[2] * cs[3] + v[3] * cs[2]) * C_MLA;
        bf16_t* q = tok < TP ? QM + (size_t)tok * 1536 + h * 192 + 128 : QS + ((size_t)((tok - TP) >> 5) * 256 + h * 32 + ((tok - TP) & 31)) * 576 + 512;
        *(unsigned*)(q + r) = cvtpk(a0, a1); *(unsigned*)(q + 32 + r) = cvtpk(b0, b1); })
    }
  }
};
struct EpiBf16 {
  bf16_t* dst; int ld; int r0; int cbase;
  DI void operator()(const AccT& acc, int wr, int wc, int fr, int fq) const {
    EPI_LOOP({ *(u32x2*)(dst + (size_t)(r0 + rl) * ld + cbase + cl) = pack4(v); })
  }
};
struct EpiQlat {
  bf16_t* QS; int h; int r0; int c0;
  DI void operator()(const AccT& acc, int wr, int wc, int fr, int fq) const {
    EPI_LOOP({ const int t = r0 + rl; *(u32x2*)(QS + ((size_t)(t >> 5) * 256 + h * 32 + (t & 31)) * 576 + c0 + cl) = pack4(v); })
  }
};
struct EpiOb {
  bf16_t* O; const bf16_t* SG; int h; int r0;
  DI void operator()(const AccT& acc, int wr, int wc, int fr, int fq) const {
    EPI_LOOP({ if (cl < 128) { const size_t idx = (size_t)(TP + r0 + rl) * 2048 + 1024 + h * 128 + cl; const f32x4 g = unpack4(*(const u32x2*)(SG + idx)); *(u32x2*)(O + idx) = pack4(v * g); } })
  }
};
struct EpiRes {
  const Params* p; const float* base;   float* dst; const float* gate;   int pm, pn;
  DI void operator()(const AccT& acc, int wr, int wc, int fr, int fq) const {
    const int r0 = pm * 256, c0 = pn * 256;
    EPI_LOOP({ const int tok = r0 + rl; const int col = c0 + cl; const float* br = base ? base + (size_t)tok * DM : x_row(*p, tok);
      const f32x4 b = *(const f32x4*)(br + col); const f32x4 g = *(const f32x4*)(gate + (size_t)tok_batch(tok) * 6144 + col);
      *(f32x4*)(dst + (size_t)tok * DM + col) = b + g * v; })
  }
};
struct EpiPart {
  float* dst;
  DI void operator()(const AccT& acc, int wr, int wc, int fr, int fq) const {
    EPI_LOOP({ *(f32x4*)(dst + (size_t)rl * 4096 + cl) = v; })
  }
};
template <int NCH> DI f32x4 part_sum(const float* PART, int row, int col) { f32x4 a = *(const f32x4*)(PART + (size_t)row * 4096 + col);
#pragma unroll
  for (int c = 1; c < NCH; ++c) a += *(const f32x4*)(PART + ((size_t)c * 512 + row) * 4096 + col);
  return a; }
constexpr int NCH5 = 4, NCH7 = 2;
struct EpiInPool {
  const Params* p; int pm, pn;
  DI void operator()(const AccT& acc, int wr, int wc, int fr, int fq) const {
    char* ws = p->ws; float* out = p->out; const int r0 = pm * 256, c0 = pn * 256;
    if (pn < 8) { float* U = (float*)(ws + W_U);
      EPI_LOOP({ const int tok = r0 + rl; const int col = c0 + cl; *(f32x4*)(U + (size_t)tok * DM + col) = v;
        if (tok < TP) { const int s = tok & 4095; if (s >= 4081) *(f32x4*)(out + O_POOLP + ((size_t)(tok >> 12) * 15 + (s - 4081)) * DM + col) = v; }
        else { const int s = (tok - TP) & 31; if (s >= 17) *(f32x4*)(out + O_POOLS + ((size_t)((tok - TP) >> 5) * 15 + (s - 17)) * DM + col) = v; } })
    } else { bf16_t* SG = (bf16_t*)(ws + W_SG);
      EPI_LOOP({ f32x4 s; s[0] = silu(v[0]); s[1] = silu(v[1]); s[2] = silu(v[2]); s[3] = silu(v[3]); *(u32x2*)(SG + (size_t)(r0 + rl) * DM + (c0 - 2048) + cl) = pack4(s); })
    }
  }
};
struct EpiGrp {
  bf16_t* MX; const bf16_t* SG; const float* scale; int r0; int c0;
  DI void operator()(const AccT& acc, int wr, int wc, int fr, int fq) const {
    EPI_LOOP({ const size_t idx = (size_t)(r0 + rl) * DM + c0 + cl; const f32x4 g = unpack4(*(const u32x2*)(SG + idx)); const f32x4 sc = *(const f32x4*)(scale + c0 + cl); *(u32x2*)(MX + idx) = pack4(v * sc * g); })
  }
};

template <int DQK, int DVW, int RG, int KSTR, int VSTR>
struct Flash {
  bf16x8 q[RG][DQK / 32];
  f32x4 o[DVW / 16][RG];
  f32x4 ol[RG];
  float m[RG];
  DI void init(const bf16_t* qp, size_t rgstride) {
#pragma unroll
    for (int rg = 0; rg < RG; ++rg) { m[rg] = 0.f; ol[rg] = (f32x4){0.f, 0.f, 0.f, 0.f};
#pragma unroll
      for (int ks = 0; ks < DQK / 32; ++ks) q[rg][ks] = *(const bf16x8*)(qp + rg * rgstride + ks * 32);
#pragma unroll
      for (int d = 0; d < DVW / 16; ++d) o[d][rg] = (f32x4){0.f, 0.f, 0.f, 0.f}; }
  }
  DI void tile(const LAS char* kt, const LAS char* vt, bool first, int nvalid) {
    const int lane = my_tid() & 63, fr = lane & 15, fq = lane >> 4;
    f32x4 s[4][RG];
#pragma unroll
    for (int kb = 0; kb < 4; ++kb)
#pragma unroll
      for (int rg = 0; rg < RG; ++rg) { const float nm = -m[rg]; s[kb][rg] = (f32x4){nm, nm, nm, nm}; }
    constexpr int KSB = (DVW > 128) ? 1 : 2;
#pragma unroll
    for (int ks0 = 0; ks0 < DQK / 32; ks0 += KSB) { bf16x8 kf[KSB][4];
#pragma unroll
      for (int kk = 0; kk < KSB; ++kk)
#pragma unroll
        for (int kb = 0; kb < 4; ++kb) kf[kk][kb] = *(const LAS bf16x8*)(kt + (kb * 16 + fr) * KSTR + ((ks0 + kk) * 32 + fq * 8) * 2);
#pragma unroll
      for (int kk = 0; kk < KSB; ++kk)
#pragma unroll
        for (int kb = 0; kb < 4; ++kb)
#pragma unroll
          for (int rg = 0; rg < RG; ++rg) s[kb][rg] = __builtin_amdgcn_mfma_f32_16x16x32_bf16(kf[kk][kb], q[rg][ks0 + kk], s[kb][rg], 0, 0, 0); }
    if (nvalid < 64) {
#pragma unroll
      for (int kb = 0; kb < 4; ++kb)
#pragma unroll
        for (int j = 0; j < 4; ++j) if (kb * 16 + fq * 4 + j >= nvalid) {
#pragma unroll
          for (int rg = 0; rg < RG; ++rg) s[kb][rg][j] = -1e30f; }
    }
    bf16x8 pf[2][RG];
#pragma unroll
    for (int rg = 0; rg < RG; ++rg) {
      float mx = s[0][rg][0];
#pragma unroll
      for (int kb = 0; kb < 4; ++kb)
#pragma unroll
        for (int j = 0; j < 4; ++j) mx = fmaxf(mx, s[kb][rg][j]);
      mx = quad_max(mx);
      if (first || !__all(mx <= 11.5f)) {
        const float dm = first ? mx : fmaxf(mx, 0.f);
        if (!first) { const float alpha = __builtin_amdgcn_exp2f(-dm);
#pragma unroll
          for (int d = 0; d < DVW / 16; ++d) o[d][rg] *= alpha;
          ol[rg] *= alpha; }
        m[rg] += dm;
#pragma unroll
        for (int kb = 0; kb < 4; ++kb) s[kb][rg] -= dm; }
#pragma unroll
      for (int kb = 0; kb < 4; ++kb)
#pragma unroll
        for (int j = 0; j < 4; ++j) s[kb][rg][j] = __builtin_amdgcn_exp2f(s[kb][rg][j]);
#pragma unroll
      for (int t = 0; t < 2; ++t) { u32x4 w; w.x = cvtpk(s[2 * t][rg][0], s[2 * t][rg][1]); w.y = cvtpk(s[2 * t][rg][2], s[2 * t][rg][3]);
        w.z = cvtpk(s[2 * t + 1][rg][0], s[2 * t + 1][rg][1]); w.w = cvtpk(s[2 * t + 1][rg][2], s[2 * t + 1][rg][3]); pf[t][rg] = __builtin_bit_cast(bf16x8, w); }
    }
    { const u32x4 o1 = {0x3F803F80u, 0x3F803F80u, 0x3F803F80u, 0x3F803F80u}; const bf16x8 ones = __builtin_bit_cast(bf16x8, o1);
#pragma unroll
      for (int t = 0; t < 2; ++t)
#pragma unroll
        for (int rg = 0; rg < RG; ++rg) ol[rg] = __builtin_amdgcn_mfma_f32_16x16x32_bf16(ones, pf[t][rg], ol[rg], 0, 0, 0); }
    const LAS char* vb = vt + (fq * 4 + (fr >> 2)) * VSTR + (fr & 3) * 8;
    constexpr int DG = (DVW > 128) ? 2 : ((DVW / 16) < 4 ? (DVW / 16) : 4);
#pragma unroll
    for (int d0 = 0; d0 < DVW / 16; d0 += DG) { bf16x8 vf[DG][2];
#pragma unroll
      for (int dd = 0; dd < DG; ++dd)
#pragma unroll
        for (int t = 0; t < 2; ++t) {
          const s16x4 lo = __builtin_amdgcn_ds_read_tr16_b64_v4i16((LAS s16x4*)(vb + (t * 32) * VSTR + (d0 + dd) * 32));
          const s16x4 hi = __builtin_amdgcn_ds_read_tr16_b64_v4i16((LAS s16x4*)(vb + (t * 32 + 16) * VSTR + (d0 + dd) * 32));
          vf[dd][t] = __builtin_shufflevector(lo, hi, 0, 1, 2, 3, 4, 5, 6, 7); }
#pragma unroll
      for (int t = 0; t < 2; ++t)
#pragma unroll
        for (int dd = 0; dd < DG; ++dd)
#pragma unroll
          for (int rg = 0; rg < RG; ++rg) o[d0 + dd][rg] = __builtin_amdgcn_mfma_f32_16x16x32_bf16(vf[dd][t], pf[t][rg], o[d0 + dd][rg], 0, 0, 0); }
  }
  DI float lsum(int rg) const { return ol[rg][0]; }
};

DI void dma16(const void* g, LAS char* ldsdst) { __builtin_amdgcn_global_load_lds((const unsigned*)g, (LAS unsigned*)ldsdst, 16, 0, 0); }

DI void unit_pd(const Params& p, LAS char* lds, int b, int h, int map, int qb) {
  constexpr int KSTR = 144, VSTR = 288, VOFF = 128 * KSTR, BUF = VOFF + 128 * VSTR;
  char* ws = p.ws; const bf16_t* QA = (const bf16_t*)(ws + W_QA);
  const int tid = my_tid(), wid = __builtin_amdgcn_readfirstlane(tid >> 6), lane = tid & 63, fr = lane & 15, fq = lane >> 4;
  if (wid >= 4) __builtin_amdgcn_s_setprio(1);
  const int tok0 = b * SEQ + qb * 256 + wid * 32;
  Flash<64, 128, 2, KSTR, VSTR> F;
  F.init(QA + (size_t)(tok0 + fr) * 1024 + h * 128 + map * 64 + fq * 8, (size_t)16 * 1024);
  const int NT2 = 2 * qb + 2, ntw = 4 * qb + (wid >> 1) + 1;
  unsigned goff[7];
#pragma unroll
  for (int k = 0; k < 7; ++k) { const int i = wid + 8 * k; const int slot = i * 64 + lane; goff[k] = 0u;
    if (i < 18) { const int r = slot / 9, c = slot - r * 9; goff[k] = (unsigned)(W_KA + ((size_t)(b * SEQ + r) * 1024 + h * 128 + map * 64 + (c < 8 ? c : 0) * 8) * 2); }
    else if (i < 54) { const int sl = slot - 1152; const int r = sl / 18, c = sl - r * 18; goff[k] = (unsigned)(W_VA + ((size_t)(b * SEQ + r) * 1024 + h * 128 + (c < 16 ? c : 0) * 8) * 2); } }
  auto issue = [&](int j, int buf) {
    LAS char* dst = lds + buf * BUF;
#pragma unroll
    for (int k = 0; k < 7; ++k) { const int i = wid + 8 * k; if (i < 54) dma16(ws + goff[k] + (size_t)j * (128 * 1024 * 2), dst + i * 1024); }
  };
  issue(0, 0); asm volatile("s_waitcnt vmcnt(0)" ::: "memory"); __syncthreads();
  for (int j = 0; j < NT2; ++j) { LAS char* tb = lds + (j & 1) * BUF;
    if (j + 1 < NT2) issue(j + 1, (j + 1) & 1);
    if (2 * j < ntw) F.tile(tb, tb + VOFF, j == 0, 64);
    if (2 * j + 1 < ntw) F.tile(tb + 64 * KSTR, tb + VOFF + 64 * VSTR, false, 64);
    asm volatile("s_waitcnt vmcnt(0)" ::: "memory"); __syncthreads();
  }
  bf16_t* OA = (bf16_t*)(ws + W_OA);
#pragma unroll
  for (int rg = 0; rg < 2; ++rg) { const float inv = 1.f / F.lsum(rg); const int tok = tok0 + rg * 16 + fr;
    bf16_t* o = OA + (((size_t)tok * 8 + h) * 2 + map) * 128 + fq * 4;
#pragma unroll
    for (int d = 0; d < 8; ++d) *(u32x2*)(o + d * 16) = pack4(F.o[d][rg] * inv); }
  __builtin_amdgcn_s_setprio(0);
}
DI void unit_pm(const Params& p, LAS char* lds, int b, int h, int qb) {
  constexpr int KSTR = 400, VSTR = 288, VOFF = 64 * KSTR, BUF = VOFF + 64 * VSTR;
  char* ws = p.ws; const bf16_t* QM = (const bf16_t*)(ws + W_QM); const bf16_t* KM = (const bf16_t*)(ws + W_KM); const bf16_t* VM = (const bf16_t*)(ws + W_VM); const bf16_t* KPE = (const bf16_t*)(ws + W_KPE);
  const int tid = my_tid(), wid = __builtin_amdgcn_readfirstlane(tid >> 6), lane = tid & 63, fr = lane & 15, fq = lane >> 4;
  if (wid >= 4) __builtin_amdgcn_s_setprio(1);
  const int tok0 = b * SEQ + qb * 256 + wid * 32;
  Flash<192, 128, 2, KSTR, VSTR> F;
  F.init(QM + (size_t)(tok0 + fr) * 1536 + h * 192 + fq * 8, (size_t)16 * 1536);
  const int NT = 4 * qb + 4, ntw = 4 * qb + (wid >> 1) + 1;
  const bf16_t* kbase = KM + (size_t)b * SEQ * 1024 + h * 128; const bf16_t* vbase = VM + (size_t)b * SEQ * 1024 + h * 128; const bf16_t* pbase = KPE + (size_t)b * SEQ * 64;
  unsigned goff[6], gstep[6];
#pragma unroll
  for (int k = 0; k < 6; ++k) { const int i = wid + 8 * k; const int slot = i * 64 + lane; goff[k] = 0u; gstep[k] = 64u * 1024u * 2u;
    if (i < 25) { const int r = slot / 25, c = slot - r * 25;
      if (c < 16) goff[k] = (unsigned)(W_KM + ((size_t)(b * SEQ + r) * 1024 + h * 128 + c * 8) * 2);
      else { goff[k] = (unsigned)(W_KPE + ((size_t)(b * SEQ + r) * 64 + (c < 24 ? c - 16 : 0) * 8) * 2); gstep[k] = 64u * 64u * 2u; } }
    else if (i < 43) { const int sl = slot - 1600; const int r = sl / 18, c = sl - r * 18; goff[k] = (unsigned)(W_VM + ((size_t)(b * SEQ + r) * 1024 + h * 128 + (c < 16 ? c : 0) * 8) * 2); } }
  auto issue = [&](int j, int buf) {
    LAS char* dst = lds + buf * BUF;
#pragma unroll
    for (int k = 0; k < 6; ++k) { const int i = wid + 8 * k; if (i < 43) dma16(ws + goff[k] + (size_t)j * gstep[k], dst + i * 1024); }
  };
  issue(0, 0); asm volatile("s_waitcnt vmcnt(0)" ::: "memory"); __syncthreads();
  for (int j = 0; j < NT; ++j) {
    if (j + 1 < NT) issue(j + 1, (j + 1) & 1);
    if (j < ntw) F.tile(lds + (j & 1) * BUF, lds + (j & 1) * BUF + VOFF, j == 0, 64);
    asm volatile("s_waitcnt vmcnt(0)" ::: "memory"); __syncthreads();
  }
  bf16_t* O = (bf16_t*)(ws + W_O); const bf16_t* SG = (const bf16_t*)(ws + W_SG);
#pragma unroll
  for (int rg = 0; rg < 2; ++rg) { const float inv = 1.f / F.lsum(rg); const int tok = tok0 + rg * 16 + fr;
    const size_t base = (size_t)tok * 2048 + 1024 + h * 128 + fq * 4;
#pragma unroll
    for (int d = 0; d < 8; ++d) { const f32x4 g = unpack4(*(const u32x2*)(SG + base + d * 16)); *(u32x2*)(O + base + d * 16) = pack4(F.o[d][rg] * inv * g); } }
  __builtin_amdgcn_s_setprio(0);
}
DI void unit_sm(const Params& p, LAS char* lds, int b, int rh, int sp) {
  constexpr int KSTR = 1168, BUF = 64 * KSTR;
  char* ws = p.ws; const bf16_t* QS = (const bf16_t*)(ws + W_QS); const bf16_t* CC = (const bf16_t*)(ws + W_CC);
  const int tid = my_tid(), wid = __builtin_amdgcn_readfirstlane(tid >> 6), lane = tid & 63, fr = lane & 15, fq = lane >> 4;
  if (wid >= 4) __builtin_amdgcn_s_setprio(1);
  const int R = rh * 128 + wid * 16 + fr;
  Flash<576, 512, 1, KSTR, KSTR> F;
  F.init(QS + ((size_t)b * 256 + R) * 576 + fq * 8, 0);
  const int j0 = sp == 0 ? 0 : 1 + sp * 16, j1 = 17 + sp * 16;
  const bf16_t* cbase = CC + (size_t)b * 4160 * 576;
  auto issue = [&](int j, int buf) {
    LAS char* dst = lds + buf * BUF;
    for (int i = wid; i < 73; i += 8) { const int slot = i * 64 + lane; const int r = slot / 73, c = slot - r * 73;
      dma16(cbase + (size_t)(j * 64 + r) * 576 + (c < 72 ? c : 0) * 8, dst + i * 1024); }
  };
  issue(j0, 0); asm volatile("s_waitcnt vmcnt(0)" ::: "memory"); __syncthreads();
  for (int j = j0; j < j1; ++j) { const int bi = (j - j0) & 1;
    if (j + 1 < j1) issue(j + 1, bi ^ 1);
    F.tile(lds + bi * BUF, lds + bi * BUF, j == j0, j == 64 ? 32 : 64);
    asm volatile("s_waitcnt vmcnt(0)" ::: "memory"); __syncthreads();
  }
  float* OPM = (float*)(ws + W_OPM); float* MLM = (float*)(ws + W_MLM);
  const float lt = F.lsum(0); const float inv = 1.f / lt; const size_t ri = ((size_t)b * 256 + R) * 4 + sp;
  float* o = OPM + ri * 512 + fq * 4;
#pragma unroll
  for (int d = 0; d < 32; ++d) *(f32x4*)(o + d * 16) = F.o[d][0] * inv;
  if (fq == 0) *(f32x2*)(MLM + ri * 2) = (f32x2){F.m[0], lt};
  __builtin_amdgcn_s_setprio(0);
}
DI void unit_sd(const Params& p, LAS char* lds, int b, int h, int sp) {
  constexpr int STR = 272, VSTR2 = 288, VOFF = 64 * STR, BUF = VOFF + 64 * VSTR2;
  char* ws = p.ws; const bf16_t* QA = (const bf16_t*)(ws + W_QA); const bf16_t* KA = (const bf16_t*)(ws + W_KA); const bf16_t* VA = (const bf16_t*)(ws + W_VA);
  const float* CK = p.in[4]; const float* CV = p.in[5];
  const int tid = my_tid(), wid = __builtin_amdgcn_readfirstlane(tid >> 6), lane = tid & 63, fr = lane & 15, fq = lane >> 4;
  if (wid >= 4) __builtin_amdgcn_s_setprio(1);
  const int map = wid & 1, dvq = wid >> 1;
  const int tokq = TP + b * 32;
  Flash<64, 32, 2, STR, VSTR2> F;
  F.init(QA + (size_t)(tokq + fr) * 1024 + h * 128 + map * 64 + fq * 8, (size_t)16 * 1024);
  const int j0 = sp == 0 ? 0 : 33, j1 = sp == 0 ? 33 : 65;
  const int lr = tid >> 3, part = tid & 7;
  f32x4 rkA[4], rvA[4], rkB[4], rvB[4];
  auto issue = [&](int j, f32x4 (&rk)[4], f32x4 (&rv)[4]) {
    if (j < 64) { const size_t off = (((size_t)b * PAST + j * 64 + lr) * 8 + h) * 128 + part * 4;
#pragma unroll
      for (int i = 0; i < 4; ++i) { rk[i] = *(const f32x4*)(CK + off + i * 32); rv[i] = *(const f32x4*)(CV + off + i * 32); } }
    else if (lr < 32) { const size_t off = (size_t)(tokq + lr) * 1024 + h * 128 + part * 4;
#pragma unroll
      for (int i = 0; i < 4; ++i) { rk[i] = unpack4(*(const u32x2*)(KA + off + i * 32)); rv[i] = unpack4(*(const u32x2*)(VA + off + i * 32)); } }
    else {
#pragma unroll
      for (int i = 0; i < 4; ++i) { rk[i] = (f32x4){0.f, 0.f, 0.f, 0.f}; rv[i] = (f32x4){0.f, 0.f, 0.f, 0.f}; } }
  };
  auto commit = [&](int buf, const f32x4 (&rk)[4], const f32x4 (&rv)[4]) {
    LAS char* kd = lds + buf * BUF + lr * STR + part * 8; LAS char* vd = lds + buf * BUF + VOFF + lr * VSTR2 + part * 8;
#pragma unroll
    for (int i = 0; i < 4; ++i) { *(LAS u32x2*)(kd + i * 64) = pack4(rk[i]); *(LAS u32x2*)(vd + i * 64) = pack4(rv[i]); }
  };
  issue(j0, rkA, rvA); if (j0 + 1 < j1) issue(j0 + 1, rkB, rvB);
  commit(0, rkA, rvA); __syncthreads();
  for (int j = j0; j < j1; j += 2) {
    if (j + 2 < j1) issue(j + 2, rkA, rvA);
    F.tile(lds + map * 128, lds + VOFF + dvq * 64, j == j0, j == 64 ? 32 : 64);
    if (j + 1 < j1) commit(1, rkB, rvB);
    __syncthreads();
    if (j + 1 < j1) {
      if (j + 3 < j1) issue(j + 3, rkB, rvB);
      F.tile(lds + BUF + map * 128, lds + BUF + VOFF + dvq * 64, false, (j + 1) == 64 ? 32 : 64);
      if (j + 2 < j1) commit(0, rkA, rvA);
      __syncthreads();
    }
  }
  float* OPD = (float*)(ws + W_OPD); float* MLD = (float*)(ws + W_MLD);
#pragma unroll
  for (int rg = 0; rg < 2; ++rg) { const float lt = F.lsum(rg); const float inv = 1.f / lt;
    const size_t ri = ((((size_t)b * 8 + h) * 2 + map) * 2 + sp) * 32 + rg * 16 + fr;
    float* o = OPD + ri * 128 + dvq * 32 + fq * 4;
#pragma unroll
    for (int d = 0; d < 2; ++d) *(f32x4*)(o + d * 16) = F.o[d][rg] * inv;
    if (dvq == 0 && fq == 0) *(f32x2*)(MLD + ri * 2) = (f32x2){F.m[rg], lt}; }
  __builtin_amdgcn_s_setprio(0);
}

template <int LAYER>
DI void phase_norm(const Params& p, LAS char* lds) {
  char* ws = p.ws; const int tid = my_tid(), wid = tid >> 6, lane = tid & 63;
  LAS float* la = (LAS float*)lds; LAS float* lsh = la + 2048;
  const float* gn = p.in[9] + LAYER * DM; const float* bada = p.in[11] + LAYER * 6144;
  const float* MODP = (const float*)(ws + W_MODP); const float* MOD = (const float*)(ws + W_MOD); const float* X1 = (const float*)(ws + W_X1);
  bf16_t* H = (bf16_t*)(ws + W_H);
  const int per = (TT + (int)gridDim.x - 1) / (int)gridDim.x; const int rbeg = blockIdx.x * per, rend = rbeg + per < TT ? rbeg + per : TT;
  for (int tok0 = rbeg; tok0 < rend;) {
    const int b = tok_batch(tok0); const int bend = tok0 < TP ? ((tok0 >> 12) + 1) << 12 : TP + ((((tok0 - TP) >> 5) + 1) << 5); const int tok1 = bend < rend ? bend : rend;
    __syncthreads();
    for (int k = tid; k < 2048; k += 512) { float sh, sc;
      if (LAYER == 0) { sh = bada[k]; sc = bada[2048 + k];
        float a8[8], b8[8];
_Pragma("unroll") for (int ks = 0; ks < 8; ++ks) { const float* mp = MODP + (((size_t)ks * 2 + 0) * NB + b) * 6144; a8[ks] = mp[k]; b8[ks] = mp[2048 + k]; }
_Pragma("unroll") for (int ks = 0; ks < 8; ++ks) { sh += a8[ks]; sc += b8[ks]; } }
      else { const float* mp = MOD + ((size_t)1 * NB + b) * 6144; sh = mp[k]; sc = mp[2048 + k]; }
      la[k] = gn[k] * (1.f + sc); lsh[k] = sh; }
    __syncthreads();
    for (int tok = tok0 + wid; tok < tok1; tok += 8) {
      const float* xr = LAYER == 0 ? x_row(p, tok) : X1 + (size_t)tok * DM;
      f32x4 v[8]; float ss = 0.f;
      if (LAYER == 1 && tok >= TP) {
        const float* x0 = x_row(p, tok); const float* g0 = MOD + (size_t)b * 6144 + 4096; const float* PART = (const float*)(ws + W_OA); float* X1w = (float*)(ws + W_X1) + (size_t)tok * DM;
#pragma unroll
        for (int i = 0; i < 8; ++i) { const int k = (i * 64 + lane) * 4; const f32x4 y = *(const f32x4*)(x0 + k) + *(const f32x4*)(g0 + k) * part_sum<NCH5>(PART, tok - TP, k); *(f32x4*)(X1w + k) = y; v[i] = y; } }
      else {
#pragma unroll
        for (int i = 0; i < 8; ++i) v[i] = *(const f32x4*)(xr + (i * 64 + lane) * 4); }
#pragma unroll
      for (int i = 0; i < 8; ++i) ss += v[i][0] * v[i][0] + v[i][1] * v[i][1] + v[i][2] * v[i][2] + v[i][3] * v[i][3];
      ss = wave_sum(ss); const float rstd = rsqrtf(ss * (1.f / 2048.f) + 1e-6f);
#pragma unroll
      for (int i = 0; i < 8; ++i) { const int k = (i * 64 + lane) * 4; const f32x4 a = *(const LAS f32x4*)(la + k); const f32x4 s = *(const LAS f32x4*)(lsh + k);
        *(u32x2*)(H + (size_t)tok * DM + k) = pack4(v[i] * rstd * a + s); } }
    tok0 = tok1;
  }
}

DI void transpose_items(const Params& p, LAS char* lds, int first, int last, int worker, int nworkers) {
  char* ws = p.ws; const int tid = my_tid(), wid = tid >> 6, lane = tid & 63;
  LAS float* tile = (LAS float*)lds + wid * (64 * 65);
  for (int it = first + worker * 8 + wid; it < last; it += nworkers * 8) {
    const float* src; bf16_t* dst; int N, Kd, nn, t; bool perm = false;
    if (it < 3104) { t = it; src = p.in[12]; N = IN_ATT; dst = (bf16_t*)(ws + W_WINT); Kd = 2048; nn = 97; }
    else if (it < 4128) { t = it - 3104; src = p.in[13]; N = 2048; dst = (bf16_t*)(ws + W_WOUTT); Kd = 2048; nn = 32; }
    else if (it < 4256) { t = it - 4128; src = p.in[20]; N = 1024; dst = (bf16_t*)(ws + W_WQT); Kd = 512; nn = 16; }
    else if (it < 4320) { t = it - 4256; src = p.in[21]; N = 512; dst = (bf16_t*)(ws + W_WQT) + (size_t)1024 * 512; Kd = 512; nn = 8; perm = true; }
    else if (it < 4448) { t = it - 4320; src = p.in[22]; N = 1024; dst = (bf16_t*)(ws + W_WKVT); Kd = 512; nn = 16; }
    else if (it < 4576) { t = it - 4448; src = p.in[23]; N = 1024; dst = (bf16_t*)(ws + W_WKVT) + (size_t)1024 * 512; Kd = 512; nn = 16; }
    else if (it < 6624) { t = it - 4576; src = p.in[25]; N = 4096; dst = (bf16_t*)(ws + W_WINPT); Kd = 2048; nn = 64; }
    else if (it < 6880) { t = it - 6624; const int g = t >> 6; t &= 63; src = p.in[26] + (size_t)g * 512 * 512; N = 512; dst = (bf16_t*)(ws + W_WGRPT) + (size_t)g * 512 * 512; Kd = 512; nn = 8; }
    else { t = it - 6880; src = p.in[28]; N = 2048; dst = (bf16_t*)(ws + W_WOUTPT); Kd = 2048; nn = 32; }
    const int n0 = (t % nn) * 64, k0 = (t / nn) * 64;
    if (it < 3104 && n0 == 4096) perm = true;
    f32x4 v[16];
#pragma unroll
    for (int i = 0; i < 16; ++i) v[i] = *(const f32x4*)(src + (size_t)(k0 + i * 4 + (lane >> 4)) * N + n0 + (lane & 15) * 4);
#pragma unroll
    for (int i = 0; i < 16; ++i) { LAS float* tp = tile + (i * 4 + (lane >> 4)) * 65 + (lane & 15) * 4; tp[0] = v[i][0]; tp[1] = v[i][1]; tp[2] = v[i][2]; tp[3] = v[i][3]; }
    asm volatile("s_waitcnt lgkmcnt(0)" ::: "memory");
    const int kc = (lane & 7) * 8;
#pragma unroll
    for (int jj = 0; jj < 8; ++jj) { const int n = jj * 8 + (lane >> 3); const int cn = perm ? ((n >> 1) + 32 * (n & 1)) : n;
      u32x4 w; w.x = cvtpk(tile[(kc + 0) * 65 + cn], tile[(kc + 1) * 65 + cn]); w.y = cvtpk(tile[(kc + 2) * 65 + cn], tile[(kc + 3) * 65 + cn]);
      w.z = cvtpk(tile[(kc + 4) * 65 + cn], tile[(kc + 5) * 65 + cn]); w.w = cvtpk(tile[(kc + 6) * 65 + cn], tile[(kc + 7) * 65 + cn]);
      *(u32x4*)(dst + (size_t)(n0 + n) * Kd + k0 + kc) = w; }
    asm volatile("s_waitcnt lgkmcnt(0)" ::: "memory");
  }
}
DI void convert_cache(const Params& p, size_t wt, size_t nwt) {
  char* ws = p.ws; bf16_t* CC = (bf16_t*)(ws + W_CC); const float* cckv = p.in[6]; const float* ckpe = p.in[7];
  for (size_t i = wt; i < (size_t)NSB * 4096 * 72; i += nwt) { const size_t row = i / 72; const int c = (int)(i - row * 72); const size_t b = row >> 12, t = row & 4095;
    const float* s = c < 64 ? cckv + row * 512 + c * 8 : ckpe + row * 64 + (c - 64) * 8; const f32x4 v0 = *(const f32x4*)s, v1 = *(const f32x4*)(s + 4);
    u32x4 w; w.x = cvtpk(v0[0], v0[1]); w.y = cvtpk(v0[2], v0[3]); w.z = cvtpk(v1[0], v1[1]); w.w = cvtpk(v1[2], v1[3]); *(u32x4*)(CC + (b * 4160 + t) * 576 + c * 8) = w; }
  for (size_t i = wt; i < (size_t)NSB * 32 * 72; i += nwt) { const size_t row = i / 72; const int c = (int)(i - row * 72); const size_t b = row >> 5, t = 4128 + (row & 31);
    *(u32x4*)(CC + (b * 4160 + t) * 576 + c * 8) = (u32x4){0u, 0u, 0u, 0u}; }
}

__global__ void __launch_bounds__(512, 2) mega(Params p) {
  extern __shared__ __attribute__((aligned(16))) char shm[];
  __shared__ int s_item;
  __shared__ uint4 xb_words;
  LAS char* lds = (LAS char*)shm;
  cg::grid_group grid = cg::this_grid();
  char* ws = p.ws; float* out = p.out;
  const int nblk = gridDim.x, bid = blockIdx.x;
  unsigned* xbar = (unsigned*)(ws + W_BAR); volatile LAS unsigned* xst = (volatile LAS unsigned*)&xb_words;
  if (threadIdx.x == 0) xb_words = make_uint4(0u, 0u, 0u, 0u);
  __syncthreads();
#define PH_VARS const int tid = my_tid(), wid = tid >> 6, lane = tid & 63; const size_t gtid = (size_t)bid * 512 + tid, gthreads = (size_t)nblk * 512; (void)wid; (void)lane; (void)gtid; (void)gthreads;

  for (int rep = 0; rep < REP_P0; ++rep) {
    PH_VARS
    if (bid == 0 && tid < 8) ((int*)(ws + W_CNT))[tid] = 0;
    if (bid == 0 && rep == 0) for (int i = tid; i < XCD_BAR_WORDS; i += 512) xbar[i] = 0u;
    { LAS float* cond = (LAS float*)lds; float* MODP = (float*)(ws + W_MODP);
      for (int it = bid; it < 2 * 24 * 8; it += nblk) { const int l = it / 192, rem = it % 192, nc = rem >> 3, ks = rem & 7;
        __syncthreads();
        for (int i = tid; i < NB * 256; i += 512) { const int b = i >> 8, kk = i & 255; const float c = b < 2 ? p.in[2][b * DM + ks * 256 + kk] : p.in[3][(b - 2) * DM + ks * 256 + kk]; cond[i] = silu(c); }
        __syncthreads();
        const int ksub = lane >> 3, n = nc * 256 + wid * 32 + (lane & 7) * 4;
        const float* w = p.in[10] + ((size_t)l * DM + ks * 256 + ksub) * 6144 + n;
        f32x4 acc[NB];
#pragma unroll
        for (int b = 0; b < NB; ++b) acc[b] = (f32x4){0.f, 0.f, 0.f, 0.f};
        for (int i8 = 0; i8 < 32; i8 += 8) { f32x4 wv[8];
#pragma unroll
          for (int j = 0; j < 8; ++j) wv[j] = *(const f32x4*)(w + (size_t)(i8 + j) * 8 * 6144);
#pragma unroll
          for (int j = 0; j < 8; ++j)
#pragma unroll
            for (int b = 0; b < NB; ++b) acc[b] += wv[j] * cond[b * 256 + ksub + (i8 + j) * 8]; }
#pragma unroll
        for (int b = 0; b < NB; ++b)
#pragma unroll
          for (int e = 0; e < 4; ++e) { float v = acc[b][e]; v += __shfl_xor(v, 8); v += __shfl_xor(v, 16); v += __shfl_xor(v, 32); acc[b][e] = v; }
        if (lane < 8) {
#pragma unroll
          for (int b = 0; b < NB; ++b) *(f32x4*)(MODP + (((size_t)ks * 2 + l) * NB + b) * 6144 + n) = acc[b]; }
      }
      __syncthreads();
    }
    transpose_items(p, lds, 0, 4576, bid, nblk);
    __syncthreads();
    { u32x4 z = {0u, 0u, 0u, 0u}; u32x4* a = (u32x4*)((bf16_t*)(ws + W_WINT) + (size_t)IN_ATT * 2048); for (size_t i = gtid; i < (size_t)192 * 2048 / 8; i += gthreads) a[i] = z;
      u32x4* c = (u32x4*)((bf16_t*)(ws + W_WKVT) + (size_t)2048 * 512); for (size_t i = gtid; i < (size_t)256 * 512 / 8; i += gthreads) c[i] = z; }
    { bf16_t* WP = (bf16_t*)(ws + W_WUKP); const float* wuk = p.in[22];
      for (size_t i = gtid; i < (size_t)8 * 512 * 256 / 4; i += gthreads) { const int e = (int)(i * 4); const int h = e >> 17, c = (e >> 8) & 511, kk = e & 255;
        f32x4 v = *(const f32x4*)(wuk + (size_t)c * 1024 + (h & ~1) * 128 + kk); if ((kk >> 7) != (h & 1)) v = (f32x4){0.f, 0.f, 0.f, 0.f}; *(u32x2*)(WP + e) = pack4(v); } }
    { float* ROPE = (float*)(ws + W_ROPE);
      for (size_t i = gtid; i < (size_t)4128 * 32; i += gthreads) { const int pos = (int)(i >> 5), r = (int)(i & 31);
        const double inv = exp2(-(double)r * (13.287712379549449 / 32.0)); double tr = (double)pos * inv * 0.15915494309189535; tr -= rint(tr);
        const float a = (float)(tr * 6.283185307179586); *(f32x2*)(ROPE + i * 2) = (f32x2){cosf(a), sinf(a)}; } }
  }
  grid.sync();
  xcd_barrier_post(xbar);
  for (int rep_e = 0; rep_e < REP_P1; ++rep_e) {
    PH_VARS
    float* MOD = (float*)(ws + W_MOD); const float* MODP = (const float*)(ws + W_MODP);
    for (size_t i = gtid; i < (size_t)2 * NB * 6144; i += gthreads) { const int l = (int)(i / (NB * 6144)); const int rem = (int)(i % (NB * 6144)); const int b = rem / 6144, n = rem % 6144;
      float s = p.in[11][l * 6144 + n]; float a8[8];
_Pragma("unroll") for (int ks = 0; ks < 8; ++ks) a8[ks] = MODP[(((size_t)ks * 2 + l) * NB + b) * 6144 + n];
_Pragma("unroll") for (int ks = 0; ks < 8; ++ks) s += a8[ks]; MOD[i] = s; }
    phase_norm<0>(p, lds);
  }
  xcd_barrier(xbar, xst);
  for (int rep = 0; rep < REP_G; ++rep) for (int t = bid; t < 34 * 25; t += nblk) { int pn, pm; tile_map(t, 34, 25, pm, pn); EpiInAtt e{&p, pm, pn};
    const bf16_t* nA = nullptr; const bf16_t* nB = nullptr;
    if (t + nblk < 34 * 25) { int qn, qm; tile_map(t + nblk, 34, 25, qm, qn); nA = (const bf16_t*)(ws + W_H) + (size_t)qm * 256 * 2048; nB = (const bf16_t*)(ws + W_WINT) + (size_t)qn * 256 * 2048; }
    gemm_tile(lds, (const bf16_t*)(ws + W_H) + (size_t)pm * 256 * 2048, 2048, (const bf16_t*)(ws + W_WINT) + (size_t)pn * 256 * 2048, 2048, 2048, e, t != bid, nA, nB); }
  {
    const int nlast = (34 * 25) % nblk; const int nw = nblk - nlast;
    if (nlast > 0 && nw > 0) { if (bid >= nlast) { transpose_items(p, lds, 4576, 7904, bid - nlast, nw); convert_cache(p, (size_t)(bid - nlast) * 512 + my_tid(), (size_t)nw * 512); } }
    else { transpose_items(p, lds, 4576, 7904, bid, nblk); convert_cache(p, (size_t)bid * 512 + my_tid(), (size_t)nblk * 512); } }
  xcd_barrier(xbar, xst);
  for (int rep_e = 0; rep_e < REP_P2B; ++rep_e) {
    PH_VARS
    const float* CQ = (const float*)(ws + W_CQ); const float* CKVR = (const float*)(ws + W_CKVR); bf16_t* CQN = (bf16_t*)(ws + W_CQN); bf16_t* CKVN = (bf16_t*)(ws + W_CKVN); bf16_t* CC = (bf16_t*)(ws + W_CC);
    const float* gqa = p.in[19]; const float* gkva = p.in[24];
    for (int tok = bid * 8 + wid; tok < TT; tok += nblk * 8) {
      { f32x4 v[2]; float ss = 0.f;
#pragma unroll
        for (int i = 0; i < 2; ++i) { v[i] = *(const f32x4*)(CQ + (size_t)tok * 512 + (i * 64 + lane) * 4); ss += v[i][0] * v[i][0] + v[i][1] * v[i][1] + v[i][2] * v[i][2] + v[i][3] * v[i][3]; }
        ss = wave_sum(ss); const float rstd = rsqrtf(ss * (1.f / 512.f) + 1e-6f);
#pragma unroll
        for (int i = 0; i < 2; ++i) { const int k = (i * 64 + lane) * 4; *(u32x2*)(CQN + (size_t)tok * 512 + k) = pack4(v[i] * rstd * *(const f32x4*)(gqa + k)); } }
      { f32x4 v[2]; float ss = 0.f;
#pragma unroll
        for (int i = 0; i < 2; ++i) { v[i] = *(const f32x4*)(CKVR + (size_t)tok * 512 + (i * 64 + lane) * 4); ss += v[i][0] * v[i][0] + v[i][1] * v[i][1] + v[i][2] * v[i][2] + v[i][3] * v[i][3]; }
        ss = wave_sum(ss); const float rstd = rsqrtf(ss * (1.f / 512.f) + 1e-6f);
        float* o = tok < TP ? out + O_CKVP + (size_t)tok * 512 : out + O_CKVS + (size_t)(tok - TP) * 512;
#pragma unroll
        for (int i = 0; i < 2; ++i) { const int k = (i * 64 + lane) * 4; const f32x4 y = v[i] * rstd * *(const f32x4*)(gkva + k); *(f32x4*)(o + k) = y; const u32x2 w = pack4(y);
          *(u32x2*)(CKVN + (size_t)tok * 512 + k) = w;
          if (tok >= TP) *(u32x2*)(CC + ((size_t)((tok - TP) >> 5) * 4160 + 4096 + ((tok - TP) & 31)) * 576 + k) = w; } }
    }
  }
  xcd_barrier(xbar, xst);
  for (int rep = 0; rep < REP_G; ++rep) {
    for (int t = bid; t < 256; t += nblk) { int pn, pm; tile_map(t, 32, 8, pm, pn); EpiBf16 e{(bf16_t*)(ws + (pn < 4 ? W_KM : W_VM)), 1024, pm * 256, (pn & 3) * 256};
      gemm_tile(lds, (const bf16_t*)(ws + W_CKVN) + (size_t)pm * 256 * 512, 512, (const bf16_t*)(ws + W_WKVT) + (size_t)pn * 256 * 512, 512, 512, e); }
    for (int t = nblk - 1 - bid; t < 204; t += nblk) { int pn, pm; tile_map(t, 34, 6, pm, pn); EpiQ e{&p, pm, pn};
      gemm_tile(lds, (const bf16_t*)(ws + W_CQN) + (size_t)pm * 256 * 512, 512, (const bf16_t*)(ws + W_WQT) + (size_t)pn * 256 * 512, 512, 512, e); }
  }
  xcd_barrier(xbar, xst);
  for (int rep = 0; rep < REP_P4; ++rep) {
    PH_VARS
    int* cnt = (int*)(ws + W_CNT) + rep;
    for (;;) {
      __syncthreads();
      if (tid == 0) s_item = atomicAdd(cnt, 1);
      __syncthreads();
      int it = s_item;
      if (it >= 1184) break;
      unsigned* qflag = (unsigned*)(ws + W_CNT) + 4;
      if (it < 32) {
        const int h = it >> 2, pm = (it >> 1) & 1, pn = it & 1; EpiQlat e{(bf16_t*)(ws + W_QS), h, pm * 256, pn * 256};
        gemm_tile(lds, (const bf16_t*)(ws + W_QNS) + (size_t)pm * 256 * 1024 + (h >> 1) * 256, 1024, (const bf16_t*)(ws + W_WUKP) + ((size_t)h * 512 + pn * 256) * 256, 256, 256, e);
        flag_publish(qflag); continue; }
      it -= 32;
      bool is_sd = false; int sdi = 0;
      if (it < 896) { const int g7 = it / 7, p7 = it - g7 * 7; is_sd = (p7 == 2) || (p7 == 5); sdi = 2 * g7 + (p7 == 5 ? 1 : 0); it -= 2 * g7 + (p7 > 2 ? 1 : 0) + (p7 > 5 ? 1 : 0); }
      else it -= 256;
      if (is_sd) { for (int r = 0; r < REP_SD; ++r) unit_sd(p, lds, sdi >> 4, (sdi >> 1) & 7, sdi & 1); }
      else if (it >= 240 && it < 368) { it -= 240; flag_wait(qflag, 32u); for (int r = 0; r < REP_SM; ++r) unit_sm(p, lds, it >> 3, (it >> 2) & 1, it & 3); }
      else { int qb; if (it < 240) { const int g = it / 48; qb = 15 - g; it -= g * 48; } else { it -= 368; const int g = it / 48; qb = 10 - g; it -= g * 48; }
        if (it < 16) { for (int r = 0; r < REP_PM; ++r) unit_pm(p, lds, it >> 3, it & 7, qb); }
        else { it -= 16; for (int r2 = 0; r2 < REP_PD; ++r2) unit_pd(p, lds, it >> 4, (it >> 1) & 7, it & 1, qb); } }
    }
  }
  xcd_barrier(xbar, xst);
  for (int rep_e = 0; rep_e < REP_P4B; ++rep_e) {
    PH_VARS
    float dq1 = wave_sum(p.in[14][lane] * p.in[15][lane]), dq2 = wave_sum(p.in[16][lane] * p.in[17][lane]);
    const float lam = __expf(dq1) - __expf(dq2) + 0.2f;
    const bf16_t* OA = (const bf16_t*)(ws + W_OA); const bf16_t* SG = (const bf16_t*)(ws + W_SG); bf16_t* O = (bf16_t*)(ws + W_O); const float* gs = p.in[18];
    const int sub = tid >> 5, e = (tid & 31) * 4;
    const f32x4 g4 = *(const f32x4*)(gs + e) * 0.8f;
    for (int pi = bid * 16 + sub; pi < TP * 8; pi += nblk * 16) { const int tok = pi >> 3, h = pi & 7;
      const f32x4 a = unpack4(*(const u32x2*)(OA + (((size_t)tok * 8 + h) * 2) * 128 + e)), b2 = unpack4(*(const u32x2*)(OA + (((size_t)tok * 8 + h) * 2 + 1) * 128 + e));
      const f32x4 o = a - lam * b2; float ss = o[0] * o[0] + o[1] * o[1] + o[2] * o[2] + o[3] * o[3];
      for (int s = 1; s <= 16; s <<= 1) ss += __shfl_xor(ss, s);
      const float rstd = rsqrtf(ss * (1.f / 128.f) + 1e-5f); const size_t idx = (size_t)tok * 2048 + h * 128 + e;
      *(u32x2*)(O + idx) = pack4(o * rstd * g4 * unpack4(*(const u32x2*)(SG + idx))); }
    { const float* OPD = (const float*)(ws + W_OPD); const float* MLD = (const float*)(ws + W_MLD);
      for (int pi = bid * 16 + sub; pi < NSB * 8 * 32; pi += nblk * 16) { const int b = pi >> 8, h = (pi >> 5) & 7, s = pi & 31;
        f32x4 om[2];
#pragma unroll
        for (int map = 0; map < 2; ++map) { const size_t r0 = ((((size_t)b * 8 + h) * 2 + map) * 2 + 0) * 32 + s, r1 = r0 + 32;
          const f32x2 ml0 = *(const f32x2*)(MLD + r0 * 2), ml1 = *(const f32x2*)(MLD + r1 * 2); const float M = fmaxf(ml0[0], ml1[0]);
          const float w0 = ml0[1] * __builtin_amdgcn_exp2f(ml0[0] - M), w1 = ml1[1] * __builtin_amdgcn_exp2f(ml1[0] - M); const float inv = 1.f / (w0 + w1);
          om[map] = (*(const f32x4*)(OPD + r0 * 128 + e) * w0 + *(const f32x4*)(OPD + r1 * 128 + e) * w1) * inv; }
        const f32x4 o = om[0] - lam * om[1]; float ss = o[0] * o[0] + o[1] * o[1] + o[2] * o[2] + o[3] * o[3];
        for (int t = 1; t <= 16; t <<= 1) ss += __shfl_xor(ss, t);
        const float rstd = rsqrtf(ss * (1.f / 128.f) + 1e-5f); const size_t idx = (size_t)(TP + b * 32 + s) * 2048 + h * 128 + e;
        *(u32x2*)(O + idx) = pack4(o * rstd * g4 * unpack4(*(const u32x2*)(SG + idx))); } }
    { const float* OPM = (const float*)(ws + W_OPM); const float* MLM = (const float*)(ws + W_MLM); bf16_t* OLAT = (bf16_t*)(ws + W_OLAT);
      const int sub4 = tid >> 7, c = (tid & 127) * 4;
      for (int ri = bid * 4 + sub4; ri < NSB * 256; ri += nblk * 4) { const int b = ri >> 8, R = ri & 255, h = R >> 5, s = R & 31;
        float mm[4], ll[4]; float M = -1e30f;
#pragma unroll
        for (int k = 0; k < 4; ++k) { const f32x2 ml = *(const f32x2*)(MLM + ((size_t)ri * 4 + k) * 2); mm[k] = ml[0]; ll[k] = ml[1]; M = fmaxf(M, ml[0]); }
        f32x4 acc = {0.f, 0.f, 0.f, 0.f}; float wsum = 0.f;
#pragma unroll
        for (int k = 0; k < 4; ++k) { const float w = ll[k] * __builtin_amdgcn_exp2f(mm[k] - M); wsum += w; acc += *(const f32x4*)(OPM + ((size_t)ri * 4 + k) * 512 + c) * w; }
        *(u32x2*)(OLAT + (((size_t)b * 32 + s) * 8 + h) * 512 + c) = pack4(acc * (1.f / wsum)); } }
  }
  xcd_barrier(xbar, xst);
  { unsigned* oflag = (unsigned*)(ws + W_CNT) + 5;
    if (bid >= nblk - 16) { const int u16 = bid - (nblk - 16); const int h = u16 >> 1, pm = u16 & 1; EpiOb e{
     (bf16_t*)(ws + W_O), (const bf16_t*)(ws + W_SG), h, pm * 256};
      gemm_tile(lds, (const bf16_t*)(ws + W_OLAT) + (size_t)pm * 256 * 4096 + h * 512, 4096, (const bf16_t*)(ws + W_WKVT) + (size_t)(1024 + h * 128) * 512, 512, 512, e);
      flag_publish(oflag); }
    for (int rep = 0; rep < REP_G; ++rep) for (int t = bid; t < 256 + 16 * NCH5; t += nblk) {
      if (t < 256) { int pn, pm; tile_map(t, 32, 8, pm, pn); EpiRes e{&p, nullptr, (float*)(ws + W_X1), (const float*)(ws + W_MOD) + 4096, pm, pn};
        gemm_tile(lds, (const bf16_t*)(ws + W_O) + (size_t)pm * 256 * 2048, 2048, (const bf16_t*)(ws + W_WOUTT) + (size_t)pn * 256 * 2048, 2048, 2048, e); }
      else { const int u = t - 256, kc = u % NCH5, tl = u / NCH5, pms = tl & 1, pn = tl >> 1; constexpr int KC = 2048 / NCH5;
        EpiPart e{(float*)(ws + W_OA) + ((size_t)kc * 512 + pms * 256) * 4096 + pn * 256};
        flag_wait(oflag, 16u);
        gemm_tile(lds, (const bf16_t*)(ws + W_O) + (size_t)(TP + pms * 256) * 2048 + kc * KC, 2048, (const bf16_t*)(ws + W_WOUTT) + (size_t)pn * 256 * 2048 + kc * KC, 2048, KC, e); }
    }
  }
  xcd_barrier(xbar, xst);
  for (int rep_e = 0; rep_e < REP_P6; ++rep_e) phase_norm<1>(p, lds);
  xcd_barrier(xbar, xst);
  auto ptrs_p7 = [&](int t, const bf16_t*& a, const bf16_t*& b2) { constexpr int KC = 2048 / NCH7;
    if (t < 512) { int pn, pm; tile_map(t, 32, 16, pm, pn); a = (const bf16_t*)(ws + W_H) + (size_t)pm * 256 * 2048; b2 = (const bf16_t*)(ws + W_WINPT) + (size_t)pn * 256 * 2048; }
    else { const int u = t - 512, kc = u % NCH7, tl = u / NCH7, pms = tl & 1, pn = tl >> 1; a = (const bf16_t*)(ws + W_H) + (size_t)(TP + pms * 256) * 2048 + kc * KC; b2 = (const bf16_t*)(ws + W_WINPT) + (size_t)pn * 256 * 2048 + kc * KC; } };
  for (int rep = 0; rep < REP_G; ++rep) for (int t = bid; t < 512 + 32 * NCH7; t += nblk) {
    const bf16_t* nA = nullptr; const bf16_t* nB = nullptr; if (t + nblk < 512 + 32 * NCH7) ptrs_p7(t + nblk, nA, nB);
    if (t < 512) { int pn, pm; tile_map(t, 32, 16, pm, pn); EpiInPool e{&p, pm, pn};
      gemm_tile(lds, (const bf16_t*)(ws + W_H) + (size_t)pm * 256 * 2048, 2048, (const bf16_t*)(ws + W_WINPT) + (size_t)pn * 256 * 2048, 2048, 2048, e, t != bid, nA, nB); }
    else { const int u = t - 512, kc = u % NCH7, tl = u / NCH7, pms = tl & 1, pn = tl >> 1; constexpr int KC = 2048 / NCH7;
      EpiPart e{(float*)(ws + W_OA) + ((size_t)kc * 512 + pms * 256) * 4096 + pn * 256};
      gemm_tile(lds, (const bf16_t*)(ws + W_H) + (size_t)(TP + pms * 256) * 2048 + kc * KC, 2048, (const bf16_t*)(ws + W_WINPT) + (size_t)pn * 256 * 2048 + kc * KC, 2048, KC, e, t != bid, nA, nB); }
  }
  xcd_barrier(xbar, xst);
  for (int rep_e = 0; rep_e < REP_P8A; ++rep_e) {
    PH_VARS
    const float* U = (const float*)(ws + W_U); bf16_t* D = (bf16_t*)(ws + W_D); const float* SP = p.in[8];
    const int c = tid * 4, g = tid >> 7;
    for (int it = bid; it < TT / 4; it += nblk) { const int tok0 = it * 4; const bool prm = tok0 < TP; const int s0 = prm ? (tok0 & 4095) : ((tok0 - TP) & 31); const int bs = prm ? 0 : (tok0 - TP) >> 5;
      const float* PART = (const float*)(ws + W_OA);
      auto fetch = [&](int s) -> f32x4 {
        if (prm) { if (s >= 0) return *(const f32x4*)(U + (size_t)(tok0 - s0 + s) * DM + c); return (f32x4){0.f, 0.f, 0.f, 0.f}; }
        if (s >= 0) return part_sum<NCH7>(PART, bs * 32 + s, c);
        return *(const f32x4*)(SP + ((size_t)bs * 15 + 15 + s) * DM + c); };
      if (!prm) {
        bf16_t* SGw = (bf16_t*)(ws + W_SG);
#pragma unroll
        for (int rr = 0; rr < 4; ++rr) { const int s = s0 + rr; const f32x4 gsum = part_sum<NCH7>(PART, bs * 32 + s, 2048 + c);
          f32x4 sg; sg[0] = silu(gsum[0]); sg[1] = silu(gsum[1]); sg[2] = silu(gsum[2]); sg[3] = silu(gsum[3]); *(u32x2*)(SGw + (size_t)(tok0 + rr) * DM + c) = pack4(sg);
          if (s >= 17) *(f32x4*)(out + O_POOLS + ((size_t)bs * 15 + (s - 17)) * DM + c) = part_sum<NCH7>(PART, bs * 32 + s, c); } }
      auto run = [&](auto wtag) { constexpr int W = decltype(wtag)::value; f32x4 r[W + 3];
#pragma unroll
        for (int j = 0; j < W + 3; ++j) r[j] = fetch(s0 - (W - 1) + j);
        f32x4 sum = r[0];
#pragma unroll
        for (int j = 1; j < W; ++j) sum += r[j];
#pragma unroll
        for (int rr = 0; rr < 4; ++rr) { const int s = s0 + rr; const float cntf = prm ? (float)(s + 1 < W ? s + 1 : W) : (float)W;
          *(u32x2*)(D + (size_t)(tok0 + rr) * DM + c) = pack4(sum * (1.f / cntf) - r[W - 1 + rr]);
          if (rr < 3) sum += r[W + rr] - r[rr]; } };
      if (g == 0) run(std::integral_constant<int, 2>{}); else if (g == 1) run(std::integral_constant<int, 4>{}); else if (g == 2) run(std::integral_constant<int, 8>{}); else run(std::integral_constant<int, 16>{});
    }
  }
  xcd_barrier(xbar, xst);
  for (int rep = 0; rep < REP_G; ++rep) for (int t = bid; t < 34 * 8; t += nblk) { int pm, gn; tile_map(t, 34, 8, pm, gn); const int g = gn >> 1, pn = gn & 1; EpiGrp e{(bf16_t*)(ws + W_MX), (const bf16_t*)(ws + W_SG), p.in[27], pm * 256, g * 512 + pn * 256};
    gemm_tile(lds, (const bf16_t*)(ws + W_D) + (size_t)pm * 256 * 2048 + g * 512, 2048, (const bf16_t*)(ws + W_WGRPT) + ((size_t)g * 512 + pn * 256) * 512, 512, 512, e); }
  xcd_barrier(xbar, xst);
  auto ptrs_p9 = [&](int t, const bf16_t*& a, const bf16_t*& b2) { constexpr int KC = 2048 / NCH5;
    if (t < 256) { int pn, pm; tile_map(t, 32, 8, pm, pn); a = (const bf16_t*)(ws + W_MX) + (size_t)pm * 256 * 2048; b2 = (const bf16_t*)(ws + W_WOUTPT) + (size_t)pn * 256 * 2048; }
    else { const int u = t - 256, kc = u % NCH5, tl = u / NCH5, pms = tl & 1, pn = tl >> 1; a = (const bf16_t*)(ws + W_MX) + (size_t)(TP + pms * 256) * 2048 + kc * KC; b2 = (const bf16_t*)(ws + W_WOUTPT) + (size_t)pn * 256 * 2048 + kc * KC; } };
  for (int rep = 0; rep < REP_G; ++rep) for (int t = bid; t < 256 + 16 * NCH5; t += nblk) {
    const bf16_t* nA = nullptr; const bf16_t* nB = nullptr; if (t + nblk < 256 + 16 * NCH5) ptrs_p9(t + nblk, nA, nB);
    if (t < 256) { int pn, pm; tile_map(t, 32, 8, pm, pn); EpiRes e{&p, (const float*)(ws + W_X1), out + O_Y, (const float*)(ws + W_MOD) + (size_t)NB * 6144 + 4096, pm, pn};
      gemm_tile(lds, (const bf16_t*)(ws + W_MX) + (size_t)pm * 256 * 2048, 2048, (const bf16_t*)(ws + W_WOUTPT) + (size_t)pn * 256 * 2048, 2048, 2048, e, t != bid, nA, nB); }
    else { const int u = t - 256, kc = u % NCH5, tl = u / NCH5, pms = tl & 1, pn = tl >> 1; constexpr int KC = 2048 / NCH5;
      EpiPart e{(float*)(ws + W_OA) + ((size_t)kc * 512 + pms * 256) * 4096 + pn * 256};
      gemm_tile(lds, (const bf16_t*)(ws + W_MX) + (size_t)(TP + pms * 256) * 2048 + kc * KC, 2048, (const bf16_t*)(ws + W_WOUTPT) + (size_t)pn * 256 * 2048 + kc * KC, 2048, KC, e, t != bid, nA, nB); }
  }
  xcd_barrier(xbar, xst);
  {
    PH_VARS
    const float* gf = p.in[29];
    for (int tok = bid * 8 + wid; tok < TT; tok += nblk * 8) { float* yr = out + O_Y + (size_t)tok * DM;
      f32x4 v[8]; float ss = 0.f;
      if (tok >= TP) {
        const float* x1r = (const float*)(ws + W_X1) + (size_t)tok * DM; const float* g1 = (const float*)(ws + W_MOD) + ((size_t)NB + tok_batch(tok)) * 6144 + 4096; const float* PART = (const float*)(ws + W_OA);
#pragma unroll
        for (int i = 0; i < 8; ++i) { const int k = (i * 64 + lane) * 4; v[i] = *(const f32x4*)(x1r + k) + *(const f32x4*)(g1 + k) * part_sum<NCH5>(PART, tok - TP, k); } }
      else {
#pragma unroll
        for (int i = 0; i < 8; ++i) v[i] = *(const f32x4*)(yr + (i * 64 + lane) * 4); }
#pragma unroll
      for (int i = 0; i < 8; ++i) ss += v[i][0] * v[i][0] + v[i][1] * v[i][1] + v[i][2] * v[i][2] + v[i][3] * v[i][3];
      ss = wave_sum(ss); const float rstd = rsqrtf(ss * (1.f / 2048.f) + 1e-6f);
#pragma unroll
      for (int i = 0; i < 8; ++i) { const int k = (i * 64 + lane) * 4; *(f32x4*)(yr + k) = v[i] * rstd * *(const f32x4*)(gf + k); } }
  }
}

extern "C" void kernel_launch(void* const* d_in, const int* in_sizes, int n_in, void* d_out, int out_size, void* d_ws, size_t ws_size, hipStream_t stream) {
  static int grid_blocks = 0;
  if (!grid_blocks) {
    int dev = 0, cus = 0, per_cu = 0;
    (void)hipGetDevice(&dev);
    (void)hipDeviceGetAttribute(&cus, hipDeviceAttributeMultiprocessorCount, dev);
    (void)hipFuncSetAttribute((const void*)mega, hipFuncAttributeMaxDynamicSharedMemorySize, DYN_LDS);
    (void)hipOccupancyMaxActiveBlocksPerMultiprocessor(&per_cu, mega, 512, DYN_LDS);
    if (per_cu < 1) { fprintf(stderr, "occupancy query returned %d\n", per_cu); per_cu = 1; }
    grid_blocks = cus;
    if (ws_size < W_END) fprintf(stderr, "workspace too small: %zu < %zu\n", ws_size, (size_t)W_END);
  }
  Params p{};
  for (int i = 0; i < 30; ++i) p.in[i] = (const float*)d_in[i];
  p.out = (float*)d_out; p.ws = (char*)d_ws;
  void* args[] = {&p};
  hipError_t e = hipLaunchCooperativeKernel((void*)mega, dim3(grid_blocks), dim3(512), args, DYN_LDS, stream);
  if (e != hipSuccess) fprintf(stderr, "cooperative launch failed: %s (grid %d)\n", hipGetErrorString(e), grid_blocks);
}
```
